# Optimizing an MI355X kernel written in HIP

```python
import math
import jax
import jax.numpy as jnp
from jax import lax
import numpy as np


D_MODEL = 1024
BATCH = 8
SEQ = 4096
DEPTH = 1

D_MIX = D_MODEL
D_FF = 2816
RMS_EPS = 1e-6
GN_EPS = 1e-5

RET_HEADS = 4
RET_DK = D_MODEL // 16
RET_DV = 2 * RET_DK
RET_CHUNK = 128
RET_THETA = 10000.0

NSA_HEADS = 8
NSA_KV_HEADS = 2
NSA_GROUP = NSA_HEADS // NSA_KV_HEADS
NSA_DH = D_MODEL // 16
CMP_LEN = 32
CMP_STRIDE = 16
CMP_HIDDEN = 256
SEL_LEN = 64
SEL_TOP = 16
WINDOW = 512
Q_BLOCK = 64
N_GATES = 3

ROPE_THETA = 500000.0
ROPE_DIM = NSA_DH // 4

NEG_INF = -1e30
FORCE_BONUS = 1e4

IN_WIDTHS = (
    RET_HEADS * RET_DK,
    RET_HEADS * RET_DK,
    RET_HEADS * RET_DV,
    RET_HEADS * RET_DV,
    NSA_HEADS * NSA_DH,
    NSA_KV_HEADS * NSA_DH,
    NSA_KV_HEADS * NSA_DH,
    NSA_KV_HEADS * NSA_DH,
    NSA_KV_HEADS * NSA_DH,
    NSA_KV_HEADS * NSA_DH,
    NSA_KV_HEADS * NSA_DH,
    NSA_HEADS * N_GATES,
)
D_IN = sum(IN_WIDTHS)

kernel_name = 'hybrid_retention_nsa_macaron'


def rms_norm(x, w):
    xf = x.astype(jnp.float32)
    y = xf * lax.rsqrt(jnp.mean(xf * xf, axis=-1, keepdims=True) + RMS_EPS)
    return (y * w.astype(jnp.float32)).astype(x.dtype)


def swiglu(h, w_gate, w_up, w_down):
    return (jax.nn.silu(h @ w_gate) * (h @ w_up)) @ w_down


def partial_rope(x, rot_dim, theta):
    seq = x.shape[1]
    half = rot_dim // 2
    inv_freq = theta ** (-2.0 * jnp.arange(half, dtype=jnp.float32) / rot_dim)
    ang = jnp.arange(seq, dtype=jnp.float32)[:, None] * inv_freq[None, :]
    cos = jnp.cos(ang)[None, :, None, :].astype(x.dtype)
    sin = jnp.sin(ang)[None, :, None, :].astype(x.dtype)
    x1 = x[..., :half]
    x2 = x[..., half:rot_dim]
    return jnp.concatenate([x1 * cos - x2 * sin, x2 * cos + x1 * sin, x[..., rot_dim:]], axis=-1)


def retention_chunkwise(q, k, v):
    bsz, seq, heads, dk = q.shape
    dv = v.shape[-1]
    c = RET_CHUNK
    n_chunks = seq // c
    gamma = 1.0 - 2.0 ** (-5.0 - jnp.arange(heads, dtype=jnp.float32))
    log_g = jnp.log(gamma)
    j = jnp.arange(c, dtype=jnp.float32)
    diff = j[:, None] - j[None, :]
    dmat = jnp.where(diff >= 0, jnp.exp(log_g[:, None, None] * jnp.maximum(diff, 0.0)), 0.0)
    xi = jnp.exp(log_g[:, None] * (j[None, :] + 1.0))
    zeta = jnp.exp(log_g[:, None] * (c - 1.0 - j[None, :]))
    g_chunk = jnp.exp(log_g * c)

    def chunks(a):
        return a.reshape(bsz, n_chunks, c, heads, a.shape[-1]).transpose(1, 0, 3, 2, 4)

    def step(state, inp):
        qi, ki, vi = inp
        inner = jnp.einsum('bhnd,bhmd->bhnm', qi, ki) * dmat
        out = (jnp.einsum('bhnm,bhme->bhne', inner, vi)
               + jnp.einsum('bhnd,bhde->bhne', qi * xi[None, :, :, None], state))
        state = (g_chunk[None, :, None, None] * state
                 + jnp.einsum('bhmd,bhme->bhde', ki * zeta[None, :, :, None], vi))
        return state, out

    state0 = jnp.zeros((bsz, heads, dk, dv), jnp.float32)
    _, out = lax.scan(step, state0, (chunks(q), chunks(k), chunks(v)))
    return out.transpose(1, 0, 3, 2, 4).reshape(bsz, seq, heads, dv)


def group_norm_heads(o, w):
    mu = jnp.mean(o, axis=-1, keepdims=True)
    var = jnp.mean(jnp.square(o - mu), axis=-1, keepdims=True)
    return (o - mu) * lax.rsqrt(var + GN_EPS) * w.astype(jnp.float32).reshape(RET_HEADS, RET_DV)


def compress_blocks(x, pe, w1, b1, w2):
    bsz, seq, hkv, dh = x.shape
    n_cmp = (seq - CMP_LEN) // CMP_STRIDE + 1
    idx = np.arange(n_cmp)[:, None] * CMP_STRIDE + np.arange(CMP_LEN)[None, :]
    blk = x[:, idx] + pe
    blk = blk.transpose(0, 1, 3, 2, 4).reshape(bsz, n_cmp, hkv, CMP_LEN * dh)
    return jax.nn.gelu(blk @ w1 + b1) @ w2


def cmp_to_sel_matrix(n_cmp, n_sel):
    c_start = np.arange(n_cmp) * CMP_STRIDE
    s_start = np.arange(n_sel) * SEL_LEN
    overlap = (np.minimum(c_start[:, None] + CMP_LEN, s_start[None, :] + SEL_LEN)
               - np.maximum(c_start[:, None], s_start[None, :]))
    return jnp.asarray(np.clip(overlap, 0, None) / CMP_LEN, dtype=jnp.float32)


def native_sparse_attention(q, k_c, v_c, k_s, v_s, k_w, v_w, gates,
                            pe_k, w1_k, b1_k, w2_k, pe_v, w1_v, b1_v, w2_v):
    bsz, seq = q.shape[:2]
    dtype = q.dtype
    n_sel = seq // SEL_LEN
    n_top = min(SEL_TOP, n_sel)
    n_qb = seq // Q_BLOCK
    scale = NSA_DH ** -0.5

    k_cmp = compress_blocks(k_c, pe_k, w1_k, b1_k, w2_k)
    v_cmp = compress_blocks(v_c, pe_v, w1_v, b1_v, w2_v)
    n_cmp = k_cmp.shape[1]
    m_cs = cmp_to_sel_matrix(n_cmp, n_sel)
    c_end = jnp.arange(n_cmp) * CMP_STRIDE + CMP_LEN - 1

    q_rot = partial_rope(q, ROPE_DIM, ROPE_THETA)
    k_s = partial_rope(k_s, ROPE_DIM, ROPE_THETA)
    k_w = partial_rope(k_w, ROPE_DIM, ROPE_THETA)

    k_sel = k_s.reshape(bsz, n_sel, SEL_LEN, NSA_KV_HEADS, NSA_DH).transpose(0, 3, 1, 2, 4)
    v_sel = v_s.reshape(bsz, n_sel, SEL_LEN, NSA_KV_HEADS, NSA_DH).transpose(0, 3, 1, 2, 4)
    pad = ((0, 0), (WINDOW, 0), (0, 0), (0, 0))
    k_win = jnp.pad(k_w, pad)
    v_win = jnp.pad(v_w, pad)

    def to_blocks(a):
        return a.reshape((bsz, n_qb, Q_BLOCK) + a.shape[2:]).swapaxes(0, 1)

    q_raw_g = q.reshape(bsz, seq, NSA_KV_HEADS, NSA_GROUP, NSA_DH)
    q_rot_g = q_rot.reshape(bsz, seq, NSA_KV_HEADS, NSA_GROUP, NSA_DH)
    b_idx = jnp.arange(bsz)[:, None, None, None]
    g_idx = jnp.arange(NSA_KV_HEADS)[None, :, None, None]
    blk_ids = jnp.arange(n_sel)
    sel_offsets = jnp.arange(SEL_LEN)

    def block(inp):
        i, qr, qp, g = inp
        t = i * Q_BLOCK + jnp.arange(Q_BLOCK)

        s_c = jnp.einsum('bqgkd,bcgd->bgkqc', qr, k_cmp).astype(jnp.float32) * scale
        mask_c = c_end[None, :] <= t[:, None]
        p_c = jax.nn.softmax(jnp.where(mask_c, s_c, NEG_INF), axis=-1) * mask_c
        o_c = jnp.einsum('bgkqc,bcgd->bqgkd', p_c.astype(dtype), v_cmp)

        imp = jnp.einsum('bgkqc,cs->bgqs', p_c, m_cs)
        cur = t // SEL_LEN
        valid = blk_ids[None, :] <= cur[:, None]
        forced = ((blk_ids[None, :] == 0) | (blk_ids[None, :] == cur[:, None])
                  | (blk_ids[None, :] == cur[:, None] - 1))
        imp = jnp.where(valid, imp + jnp.where(forced, FORCE_BONUS, 0.0), NEG_INF)
        _, sel = lax.top_k(imp, n_top)

        k_g = k_sel[b_idx, g_idx, sel]
        v_g = v_sel[b_idx, g_idx, sel]
        s_s = jnp.einsum('bqgkd,bgqnld->bgkqnl', qp, k_g).astype(jnp.float32) * scale
        kpos = sel[..., None] * SEL_LEN + sel_offsets
        mask_s = (kpos <= t[None, None, :, None, None])[:, :, None]
        s_s = jnp.where(mask_s, s_s, NEG_INF).reshape(bsz, NSA_KV_HEADS, NSA_GROUP, Q_BLOCK, n_top * SEL_LEN)
        p_s = jax.nn.softmax(s_s, axis=-1).reshape(bsz, NSA_KV_HEADS, NSA_GROUP, Q_BLOCK, n_top, SEL_LEN)
        o_s = jnp.einsum('bgkqnl,bgqnld->bqgkd', p_s.astype(dtype), v_g)

        kw_blk = lax.dynamic_slice_in_dim(k_win, i * Q_BLOCK, Q_BLOCK + WINDOW, axis=1)
        vw_blk = lax.dynamic_slice_in_dim(v_win, i * Q_BLOCK, Q_BLOCK + WINDOW, axis=1)
        wpos = i * Q_BLOCK - WINDOW + jnp.arange(Q_BLOCK + WINDOW)
        mask_w = ((wpos[None, :] <= t[:, None]) & (wpos[None, :] > t[:, None] - WINDOW)
                  & (wpos[None, :] >= 0))
        s_w = jnp.einsum('bqgkd,bjgd->bgkqj', qp, kw_blk).astype(jnp.float32) * scale
        p_w = jax.nn.softmax(jnp.where(mask_w, s_w, NEG_INF), axis=-1)
        o_w = jnp.einsum('bgkqj,bjgd->bqgkd', p_w.astype(dtype), vw_blk)

        return g[..., 0:1] * o_c + g[..., 1:2] * o_s + g[..., 2:3] * o_w

    out = lax.map(block, (jnp.arange(n_qb), to_blocks(q_raw_g), to_blocks(q_rot_g), to_blocks(gates)))
    return out.swapaxes(0, 1).reshape(bsz, seq, NSA_HEADS * NSA_DH)


def setup_inputs(seed: int = 0) -> dict:
    key = jax.random.key(seed)
    ks = jax.random.split(key, 24)
    f32 = jnp.float32

    def nrm(k, shape, scale):
        return jax.random.normal(k, shape, f32) * scale

    def gain(k, n):
        return 1.0 + 0.1 * jax.random.normal(k, (DEPTH, n), f32)

    flat = CMP_LEN * NSA_DH
    return {
        'x': nrm(ks[0], (BATCH, SEQ, D_MODEL), 1.0),
        'ffn1_norm_w': gain(ks[1], D_MODEL),
        'ffn1_w_gate': nrm(ks[2], (DEPTH, D_MODEL, D_FF), D_MODEL ** -0.5),
        'ffn1_w_up': nrm(ks[3], (DEPTH, D_MODEL, D_FF), D_MODEL ** -0.5),
        'ffn1_w_down': nrm(ks[4], (DEPTH, D_FF, D_MODEL), D_FF ** -0.5),
        'mix_norm_w': gain(ks[5], D_MODEL),
        'w_in': nrm(ks[6], (DEPTH, D_MODEL, D_IN), D_MODEL ** -0.5),
        'ret_norm_w': gain(ks[7], RET_HEADS * RET_DV),
        'cmp_pe_k': nrm(ks[8], (DEPTH, CMP_LEN, NSA_KV_HEADS, NSA_DH), 0.02),
        'cmp_k_w1': nrm(ks[9], (DEPTH, flat, CMP_HIDDEN), flat ** -0.5),
        'cmp_k_b1': nrm(ks[10], (DEPTH, CMP_HIDDEN), 0.01),
        'cmp_k_w2': nrm(ks[11], (DEPTH, CMP_HIDDEN, NSA_DH), CMP_HIDDEN ** -0.5),
        'cmp_pe_v': nrm(ks[12], (DEPTH, CMP_LEN, NSA_KV_HEADS, NSA_DH), 0.02),
        'cmp_v_w1': nrm(ks[13], (DEPTH, flat, CMP_HIDDEN), flat ** -0.5),
        'cmp_v_b1': nrm(ks[14], (DEPTH, CMP_HIDDEN), 0.01),
        'cmp_v_w2': nrm(ks[15], (DEPTH, CMP_HIDDEN, NSA_DH), CMP_HIDDEN ** -0.5),
        'w_out': nrm(ks[16], (DEPTH, D_MIX, D_MODEL), D_MIX ** -0.5),
        'ffn2_norm_w': gain(ks[17], D_MODEL),
        'ffn2_w_gate': nrm(ks[18], (DEPTH, D_MODEL, D_FF), D_MODEL ** -0.5),
        'ffn2_w_up': nrm(ks[19], (DEPTH, D_MODEL, D_FF), D_MODEL ** -0.5),
        'ffn2_w_down': nrm(ks[20], (DEPTH, D_FF, D_MODEL), D_FF ** -0.5),
        'final_norm_w': 1.0 + 0.1 * jax.random.normal(ks[21], (D_MODEL,), f32),
    }


def reference(x, ffn1_norm_w, ffn1_w_gate, ffn1_w_up, ffn1_w_down, mix_norm_w, w_in,
              ret_norm_w, cmp_pe_k, cmp_k_w1, cmp_k_b1, cmp_k_w2, cmp_pe_v, cmp_v_w1,
              cmp_v_b1, cmp_v_w2, w_out, ffn2_norm_w, ffn2_w_gate, ffn2_w_up, ffn2_w_down,
              final_norm_w):
    bsz, seq, _ = x.shape
    dtype = x.dtype
    offsets = tuple(int(o) for o in np.cumsum(IN_WIDTHS)[:-1])
    h = x
    for layer in range(DEPTH):
        h = h + 0.5 * swiglu(rms_norm(h, ffn1_norm_w[layer]), ffn1_w_gate[layer],
                             ffn1_w_up[layer], ffn1_w_down[layer])

        u = rms_norm(h, mix_norm_w[layer])
        proj = u @ w_in[layer]
        (rq, rk, rv, rg, nq, kc, vc, ksel, vsel, kwin, vwin, ng) = jnp.split(proj, offsets, axis=-1)

        rq = partial_rope(rq.reshape(bsz, seq, RET_HEADS, RET_DK), RET_DK, RET_THETA)
        rk = partial_rope(rk.reshape(bsz, seq, RET_HEADS, RET_DK), RET_DK, RET_THETA) * (RET_DK ** -0.5)
        rv = rv.reshape(bsz, seq, RET_HEADS, RET_DV)
        ret = retention_chunkwise(rq.astype(jnp.float32), rk.astype(jnp.float32), rv.astype(jnp.float32))
        ret = group_norm_heads(ret, ret_norm_w[layer]).astype(dtype).reshape(bsz, seq, RET_HEADS * RET_DV)
        ret = ret * jax.nn.silu(rg)

        kv_shape = (bsz, seq, NSA_KV_HEADS, NSA_DH)
        gates = jax.nn.sigmoid(ng).reshape(bsz, seq, NSA_KV_HEADS, NSA_GROUP, N_GATES)
        nsa = native_sparse_attention(
            nq.reshape(bsz, seq, NSA_HEADS, NSA_DH),
            kc.reshape(kv_shape), vc.reshape(kv_shape),
            ksel.reshape(kv_shape), vsel.reshape(kv_shape),
            kwin.reshape(kv_shape), vwin.reshape(kv_shape), gates,
            cmp_pe_k[layer], cmp_k_w1[layer], cmp_k_b1[layer], cmp_k_w2[layer],
            cmp_pe_v[layer], cmp_v_w1[layer], cmp_v_b1[layer], cmp_v_w2[layer])

        h = h + jnp.concatenate([ret, nsa], axis=-1) @ w_out[layer]

        h = h + 0.5 * swiglu(rms_norm(h, ffn2_norm_w[layer]), ffn2_w_gate[layer],
                             ffn2_w_up[layer], ffn2_w_down[layer])
    return rms_norm(h, final_norm_w)
```

```cpp
#include <hip/hip_runtime.h>
#include <hip/hip_cooperative_groups.h>
#include <cstdio>
#include <cstdint>
namespace cg = cooperative_groups;
namespace pg8 {
#define PG8_LAS __attribute__((address_space(3)))
typedef unsigned short bf16_t;
typedef short bf16x8 __attribute__((ext_vector_type(8)));
typedef float f32x4 __attribute__((ext_vector_type(4)));
typedef unsigned u32x4 __attribute__((ext_vector_type(4)));
constexpr int BM = 256, BK = 64, HALF = 128, HTB = HALF * BK * 2  , STAGE_BYTES = 8 * HTB, NXCD = 8;

__host__ __device__ __forceinline__ int lds_byte(int r, int c) { const int st = (r >> 4) * 2 + (c >> 5), rr = r & 15, cc = c & 31, ob = rr * 64 + cc * 2; return st * 1024 + (ob ^ (((ob >> 9) & 1) << 5)); }
__host__ __device__ __forceinline__ void stage_rc(int b, int& R, int& C) { const int st = b / 1024, sb = b % 1024, swz = sb ^ (((sb >> 9) & 1) << 5); R = (st >> 1) * 16 + swz / 64; C = (st & 1) * 32 + (swz % 64) / 2; }
__host__ __device__ __forceinline__ int perm32(int rho) { const int n = rho >> 4, i = rho & 15; return 8 * (i >> 2) + 4 * n + (i & 3); }

struct Unit { int pm, pn; };
struct Gemm { const bf16_t* A; const bf16_t* Bt; int M, N, K; };

struct StaticOrder {
    int nM, nN, nwg, G, c, WGM;
    __host__ __device__ void init(int M, int N, int G_, int c_, int wgm = 4) { nM = M / BM; nN = N / BM; nwg = nM * nN; G = G_; c = c_; WGM = wgm; }
    __host__ __device__ bool next(int i, Unit& u) const {
        const long L = (long)i * G + c; if (L >= nwg) return false;
        int wgid = (int)L; { const int q = nwg / NXCD, r = nwg % NXCD, xcd = wgid % NXCD, off = wgid / NXCD; wgid = (xcd < r ? xcd * (q + 1) : r * (q + 1) + (xcd - r) * q) + off; }
        const int nig = WGM * nN, gid = wgid / nig, fm = gid * WGM, gsz = (nM - fm) < WGM ? (nM - fm) : WGM;
        u.pm = fm + ((wgid % nig) % gsz); u.pn = (wgid % nig) / gsz; return true;
    }
    __device__ __forceinline__ void a_ready(const Unit&) const {}
    __device__ __forceinline__ void done(const Unit&) const {}
};
typedef float f32x2_t __attribute__((ext_vector_type(2))); typedef __bf16 bf16x2_t __attribute__((ext_vector_type(2)));
__device__ __forceinline__ unsigned cvt_pk_bf16(float lo, float hi) { f32x2_t v = {lo, hi}; bf16x2_t b = __builtin_convertvector(v, bf16x2_t); return __builtin_bit_cast(unsigned, b); }
typedef unsigned u32x2 __attribute__((ext_vector_type(2)));
template <int X> __device__ __forceinline__ float xswz(float v) { return __int_as_float(__builtin_amdgcn_ds_swizzle(__float_as_int(v), 0x1f | (X << 10))); }
template <int X> __device__ __forceinline__ unsigned xswzu(unsigned v) { return (unsigned)__builtin_amdgcn_ds_swizzle((int)v, 0x1f | (X << 10)); }
__device__ __forceinline__ float sum_x32(float v) { auto rr = __builtin_amdgcn_permlane32_swap(__float_as_uint(v), __float_as_uint(v), false, false); return __uint_as_float(rr[0]) + __uint_as_float(rr[1]); }
__device__ __forceinline__ float max_x32(float v) { auto rr = __builtin_amdgcn_permlane32_swap(__float_as_uint(v), __float_as_uint(v), false, false); return fmaxf(__uint_as_float(rr[0]), __uint_as_float(rr[1])); }
__device__ __forceinline__ unsigned or_x32(unsigned v) { auto rr = __builtin_amdgcn_permlane32_swap(v, v, false, false); return rr[0] | rr[1]; }
__device__ __forceinline__ float sum_g(float v) { v += xswz<16>(v); return sum_x32(v); }
__device__ __forceinline__ float max_g(float v) { v = fmaxf(v, xswz<16>(v)); return max_x32(v); }

__device__ __forceinline__ float silu_f(float x) { return x * __builtin_amdgcn_rcpf(1.0f + __expf(-x)); }

template <bool SCALE> struct EpiGateUp {
    static constexpr bool PERM = true, AFTER_DRAIN = false; static constexpr int NEP = 8;
    bf16_t* O; int ldo; const float* ssq;
    __device__ __forceinline__ void operator()(const f32x4 (&acc)[2][2][4][2], const Unit& u, int wr, int wc, int fr, int fq) const {
        const int row0 = u.pm * BM + wr * 64 + fr, col0 = u.pn * HALF + wc * 32 + 8 * fq;
        float rs[8];
        if (SCALE) {
#pragma unroll
            for (int k = 0; k < 8; ++k) rs[k] = ssq[row0 + (k >> 2) * HALF + (k & 3) * 16];
#pragma unroll
            for (int k = 0; k < 8; ++k) rs[k] = __builtin_amdgcn_rsqf(rs[k] * (1.0f / 1024.0f) + 1e-6f);
        }
#pragma unroll
        for (int ai = 0; ai < 2; ++ai)
#pragma unroll
            for (int m = 0; m < 4; ++m) {
                const int row = row0 + ai * HALF + m * 16;
                const float r = SCALE ? rs[ai * 4 + m] : 1.0f, k1 = -1.4426950408889634f * r, r2 = r * r;
                typedef float f32x2 __attribute__((ext_vector_type(2)));
                unsigned wv[4];
#pragma unroll
                for (int n = 0; n < 2; ++n)
#pragma unroll
                    for (int p = 0; p < 2; ++p) {
                        const f32x2 g = (f32x2){acc[ai][0][m][n][2 * p], acc[ai][0][m][n][2 * p + 1]}, up = (f32x2){acc[ai][1][m][n][2 * p], acc[ai][1][m][n][2 * p + 1]};
                        const f32x2 t = g * k1; f32x2 ex; ex.x = __builtin_amdgcn_exp2f(t.x); ex.y = __builtin_amdgcn_exp2f(t.y);
                        const f32x2 d = ex + 1.0f; f32x2 rc; rc.x = __builtin_amdgcn_rcpf(d.x); rc.y = __builtin_amdgcn_rcpf(d.y);
                        f32x2 gu = g * up; if (SCALE) gu = gu * r2;
                        const f32x2 h = gu * rc;
                        wv[n * 2 + p] = cvt_pk_bf16(h.x, h.y);
                    }
                u32x4 w; w.x = wv[0]; w.y = wv[1]; w.z = wv[2]; w.w = wv[3];
                __builtin_nontemporal_store(w, (u32x4*)(O + (size_t)row * ldo + col0));
            }
    }
};

template <bool XF> struct EpiResid {
    static constexpr bool PERM = true, AFTER_DRAIN = false; static constexpr int NEP = 16;
    const float* xf; bf16_t* hb; float* ssq; float coef; float ssqw;
    __device__ __forceinline__ void ldbase(f32x4 (&b)[2][2], int row, int col0) const {
#pragma unroll
        for (int bj = 0; bj < 2; ++bj) { const size_t off = (size_t)row * 1024 + col0 + bj * HALF;
            if (XF) { b[bj][0] = __builtin_nontemporal_load((const f32x4*)(xf + off)); b[bj][1] = __builtin_nontemporal_load((const f32x4*)(xf + off + 4)); }
            else { const u32x4 hv = __builtin_nontemporal_load((const u32x4*)(hb + off)); b[bj][0] = __builtin_bit_cast(f32x4, hv); } }
    }
    __device__ __forceinline__ void operator()(const f32x4 (&acc)[2][2][4][2], const Unit& u, int wr, int wc, int fr, int fq) const {
        const int row0 = u.pm * BM + wr * 64 + fr, col0 = u.pn * BM + wc * 32 + 8 * fq;
        f32x4 bb[2][2][2];
        ldbase(bb[0], row0, col0);
#pragma unroll
        for (int k = 0; k < 8; ++k) {
            const int ai = k >> 2, m = k & 3, row = row0 + ai * HALF + m * 16;
            if (k + 1 < 8) ldbase(bb[(k + 1) & 1], row0 + ((k + 1) >> 2) * HALF + ((k + 1) & 3) * 16, col0);
            f32x4 ssv = (f32x4){0.f, 0.f, 0.f, 0.f};
#pragma unroll
            for (int bj = 0; bj < 2; ++bj) {
                const size_t off = (size_t)row * 1024 + col0 + bj * HALF;
                f32x4 b0, b1;
                if (XF) { b0 = bb[k & 1][bj][0]; b1 = bb[k & 1][bj][1]; }
                else { const u32x4 hv = __builtin_bit_cast(u32x4, bb[k & 1][bj][0]);
                    b0 = (f32x4){__uint_as_float(hv.x << 16), __uint_as_float(hv.x & 0xffff0000u), __uint_as_float(hv.y << 16), __uint_as_float(hv.y & 0xffff0000u)};
                    b1 = (f32x4){__uint_as_float(hv.z << 16), __uint_as_float(hv.z & 0xffff0000u), __uint_as_float(hv.w << 16), __uint_as_float(hv.w & 0xffff0000u)}; }
                const f32x4 v0 = b0 + acc[ai][bj][m][0] * coef, v1 = b1 + acc[ai][bj][m][1] * coef;
                ssv = ssv + v0 * v0; ssv = ssv + v1 * v1;
                u32x4 w; w.x = cvt_pk_bf16(v0[0], v0[1]); w.y = cvt_pk_bf16(v0[2], v0[3]); w.z = cvt_pk_bf16(v1[0], v1[1]); w.w = cvt_pk_bf16(v1[2], v1[3]); __builtin_nontemporal_store(w, (u32x4*)(hb + off));
            }
            float ss = (ssv[0] + ssv[1]) + (ssv[2] + ssv[3]);
            ss = sum_g(ss) * ssqw;
            if (fq == 0) atomicAdd(ssq + row, ss);
        }
    }
};

struct EpiFinal {
    static constexpr bool PERM = true, AFTER_DRAIN = false; static constexpr int NEP = 32;
    const bf16_t* hb; float* out; float* ssq; unsigned* cnt; const float* w; float coef;
    __device__ __forceinline__ void ldbase(u32x4 (&b)[2], int row, int col0) const {
#pragma unroll
        for (int bj = 0; bj < 2; ++bj) b[bj] = __builtin_nontemporal_load((const u32x4*)(hb + (size_t)row * 1024 + col0 + bj * HALF));
    }
    __device__ __forceinline__ void operator()(f32x4 (&acc)[2][2][4][2], const Unit& u, int wr, int wc, int fr, int fq) const {
        const int row0 = u.pm * BM + wr * 64 + fr, col0 = u.pn * BM + wc * 32 + 8 * fq;
        u32x4 bb[2][2];
        ldbase(bb[0], row0, col0);
#pragma unroll
        for (int k = 0; k < 8; ++k) {
            const int ai = k >> 2, m = k & 3, row = row0 + ai * HALF + m * 16;
            if (k + 1 < 8) ldbase(bb[(k + 1) & 1], row0 + ((k + 1) >> 2) * HALF + ((k + 1) & 3) * 16, col0);
            f32x4 ssv = (f32x4){0.f, 0.f, 0.f, 0.f};
#pragma unroll
            for (int bj = 0; bj < 2; ++bj) {
                const u32x4 hv = bb[k & 1][bj];
                const f32x4 b0 = (f32x4){__uint_as_float(hv.x << 16), __uint_as_float(hv.x & 0xffff0000u), __uint_as_float(hv.y << 16), __uint_as_float(hv.y & 0xffff0000u)};
                const f32x4 b1 = (f32x4){__uint_as_float(hv.z << 16), __uint_as_float(hv.z & 0xffff0000u), __uint_as_float(hv.w << 16), __uint_as_float(hv.w & 0xffff0000u)};
                const f32x4 v0 = b0 + acc[ai][bj][m][0] * coef, v1 = b1 + acc[ai][bj][m][1] * coef;
                acc[ai][bj][m][0] = v0; acc[ai][bj][m][1] = v1;
                ssv = ssv + v0 * v0; ssv = ssv + v1 * v1;
            }
            float ss = (ssv[0] + ssv[1]) + (ssv[2] + ssv[3]);
            ss = sum_g(ss);
            if (fq == 0) atomicAdd(ssq + row, ss);
        }
        asm volatile("s_waitcnt vmcnt(0)" ::: "memory");
        __builtin_amdgcn_s_barrier();
        if (threadIdx.x == 0) {
            __builtin_amdgcn_fence(__ATOMIC_RELEASE, "agent");
            __hip_atomic_fetch_add(cnt + 64 * u.pm, 1u, __ATOMIC_RELAXED, __HIP_MEMORY_SCOPE_AGENT);
            unsigned sp = 0;
            while (__hip_atomic_load(cnt + 64 * u.pm, __ATOMIC_RELAXED, __HIP_MEMORY_SCOPE_AGENT) < 4u) { __builtin_amdgcn_s_sleep(2); if (++sp > (1u << 20)) break; }
            __builtin_amdgcn_fence(__ATOMIC_ACQUIRE, "agent");
        }
        asm volatile("s_waitcnt vmcnt(0) lgkmcnt(0)" ::: "memory");
        __builtin_amdgcn_s_barrier();
        asm volatile("" ::: "memory");
        f32x4 wv[2][2];
#pragma unroll
        for (int bj = 0; bj < 2; ++bj) { wv[bj][0] = *(const f32x4*)(w + col0 + bj * HALF); wv[bj][1] = *(const f32x4*)(w + col0 + bj * HALF + 4); }
        float rs[8];
#pragma unroll
        for (int k = 0; k < 8; ++k) rs[k] = __hip_atomic_load(ssq + row0 + (k >> 2) * HALF + (k & 3) * 16, __ATOMIC_RELAXED, __HIP_MEMORY_SCOPE_AGENT);
#pragma unroll
        for (int k = 0; k < 8; ++k) rs[k] = __builtin_amdgcn_rsqf(rs[k] * (1.0f / 1024.0f) + 1e-6f);
#pragma unroll
        for (int ai = 0; ai < 2; ++ai)
#pragma unroll
            for (int m = 0; m < 4; ++m) {
                const int row = row0 + ai * HALF + m * 16;
                const float r = rs[ai * 4 + m];
#pragma unroll
                for (int bj = 0; bj < 2; ++bj) {
                    const size_t off = (size_t)row * 1024 + col0 + bj * HALF;
                    __builtin_nontemporal_store(acc[ai][bj][m][0] * r * wv[bj][0], (f32x4*)(out + off)); __builtin_nontemporal_store(acc[ai][bj][m][1] * r * wv[bj][1], (f32x4*)(out + off + 4));
                }
            }
    }
};

struct EpiIn {
    static constexpr bool PERM = true, AFTER_DRAIN = false; static constexpr int NEP = 16;
    bf16_t* P; bf16_t* QR; const float* ssq;
    __device__ __forceinline__ void operator()(const f32x4 (&acc)[2][2][4][2], const Unit& u, int wr, int wc, int fr, int fq) const {
        const int row0 = u.pm * BM + wr * 64 + fr, cw = wc * 32 + 8 * fq, col0 = u.pn * BM + cw;
        const int pn = u.pn;
        const int q8 = ((cw & 63) >> 3);
        const bool isret = pn <= 1, isnsa = (pn == 6 || pn == 7 || pn == 9 || pn == 10);
        f32x4 fr0 = (f32x4){0.f, 0.f, 0.f, 0.f}, fr1 = fr0;
        if (isret) {
#pragma unroll
            for (int j = 0; j < 4; ++j) fr0[j] = __builtin_amdgcn_exp2f(-(float)(4 * q8 + j) * (2.0f / 64.0f) * 13.287712379549449f) * 0.15915494309189535f;
        } else if (isnsa) {
#pragma unroll
            for (int j = 0; j < 4; ++j) { fr0[j] = __builtin_amdgcn_exp2f(-(float)j * (2.0f / 16.0f) * 18.931568569324174f) * 0.15915494309189535f;
                                          fr1[j] = __builtin_amdgcn_exp2f(-(float)(4 + j) * (2.0f / 16.0f) * 18.931568569324174f) * 0.15915494309189535f; }
        }
        float rs[8];
#pragma unroll
        for (int k = 0; k < 8; ++k) rs[k] = ssq[row0 + (k >> 2) * HALF + (k & 3) * 16];
#pragma unroll
        for (int k = 0; k < 8; ++k) rs[k] = __builtin_amdgcn_rsqf(rs[k] * (1.0f / 1024.0f) + 1e-6f);
#pragma unroll
        for (int ai = 0; ai < 2; ++ai)
#pragma unroll
            for (int m = 0; m < 4; ++m) {
                const int row = row0 + ai * HALF + m * 16; const float pos = (float)(row & 4095);
                const float r = rs[ai * 4 + m];
                f32x4 c0 = (f32x4){1.f, 1.f, 1.f, 1.f}, s0 = (f32x4){0.f, 0.f, 0.f, 0.f}, c1 = c0, s1 = s0;
                if (isret || isnsa) {
#pragma unroll
                    for (int j = 0; j < 4; ++j) { const float a0 = __builtin_amdgcn_fractf(pos * fr0[j]); c0[j] = __builtin_amdgcn_cosf(a0); s0[j] = __builtin_amdgcn_sinf(a0); }
                    if (isnsa) {
#pragma unroll
                        for (int j = 0; j < 4; ++j) { const float a1 = __builtin_amdgcn_fractf(pos * fr1[j]); c1[j] = __builtin_amdgcn_cosf(a1); s1[j] = __builtin_amdgcn_sinf(a1); }
                    }
                }
#pragma unroll
                for (int bj = 0; bj < 2; ++bj) {
                    f32x4 v0 = acc[ai][bj][m][0] * r, v1 = acc[ai][bj][m][1] * r;
                    bf16_t* dst = P + (size_t)row * 3072 + col0 + bj * HALF;
                    if (isret) {
                        f32x4 o0 = v0 * c0 - v1 * s0, o1 = v1 * c0 + v0 * s0;
                        if (pn == 1) { o0 = o0 * 0.125f; o1 = o1 * 0.125f; }
                        v0 = o0; v1 = o1;
                    } else if (pn == 6 || pn == 7 || ((pn == 9 || pn == 10) && bj == 0)) {
                        if (pn <= 7) { u32x4 w; w.x = cvt_pk_bf16(v0[0], v0[1]); w.y = cvt_pk_bf16(v0[2], v0[3]); w.z = cvt_pk_bf16(v1[0], v1[1]); w.w = cvt_pk_bf16(v1[2], v1[3]); *(u32x4*)dst = w;
                                       dst = QR + (size_t)row * 512 + (pn - 6) * BM + bj * HALF + cw; }
                        f32x4 p0, p1;
#pragma unroll
                        for (int j = 0; j < 4; ++j) { p0[j] = xswz<16>(v0[j]); p1[j] = xswz<16>(v1[j]); }
                        if (q8 == 0) { v0 = v0 * c0 - p0 * s0; v1 = v1 * c1 - p1 * s1; }
                        else if (q8 == 1) { v0 = v0 * c0 + p0 * s0; v1 = v1 * c1 + p1 * s1; }
                    }
                    u32x4 w; w.x = cvt_pk_bf16(v0[0], v0[1]); w.y = cvt_pk_bf16(v0[2], v0[3]); w.z = cvt_pk_bf16(v1[0], v1[1]); w.w = cvt_pk_bf16(v1[2], v1[3]);
                    __builtin_nontemporal_store(w, (u32x4*)dst);
                }
            }
    }
};
template <class Epi, class Sched, bool ALIGN_EPI = false, bool SP2 = false>
__device__ __forceinline__ void gemm_phase(PG8_LAS unsigned char* lds, const Gemm g, const Sched& S, const Epi& E) {
    const int tid = threadIdx.x, wid = __builtin_amdgcn_readfirstlane(tid >> 6), lane = tid & 63, wr = wid >> 2, wc = wid & 3, fr = lane & 15, fq = lane >> 4;
    const int K = g.K, nt = K / BK;
    unsigned voffA[2], voffB[2];
#pragma unroll
    for (int i = 0; i < 2; ++i) { int R, C; stage_rc(tid * 16 + i * 8192, R, C); const int Rb = Epi::PERM ? ((R & ~31) + perm32(R & 31)) : R;
        voffA[i] = (unsigned)(R * K + C) * 2u; voffB[i] = (unsigned)(Rb * K + C) * 2u; }
    const size_t kstep = (size_t)(BK * 2);
    const size_t hstep = (size_t)HALF * K * 2;
    const size_t tstep = 2 * hstep;
    const unsigned ldsw = (unsigned)wid * 1024u;
    const int aoff = lds_byte(wr * 64 + fr, fq * 8), boff = lds_byte(wc * 32 + fr, fq * 8);
#define PG8_SA(b, h) (((b) * 2 + (h)) * HTB)
#define PG8_SB(b, h) ((4 + (b) * 2 + (h)) * HTB)
#define PG8_STAGE(bufoff, gbase, voff) do { _Pragma("unroll") for (int _i = 0; _i < 2; ++_i) \
        __builtin_amdgcn_global_load_lds((const unsigned*)((const char*)(gbase) + (voff)[_i]), (PG8_LAS unsigned*)(lds + (bufoff) + ldsw + _i * 8192), 16, 0, 0); } while (0)
#define PG8_LDA(dst, b, h) do { _Pragma("unroll") for (int m = 0; m < 4; ++m) _Pragma("unroll") for (int k = 0; k < 2; ++k) dst[m][k] = *(const PG8_LAS bf16x8*)(lds + PG8_SA(b, h) + aoff + m * 2048 + k * 1024); } while (0)
#define PG8_LDB(dst, b, h) do { _Pragma("unroll") for (int n = 0; n < 2; ++n) _Pragma("unroll") for (int k = 0; k < 2; ++k) dst[n][k] = *(const PG8_LAS bf16x8*)(lds + PG8_SB(b, h) + boff + n * 2048 + k * 1024); } while (0)
#define PG8_MMA(ai, bj, At, Bt) do { __builtin_amdgcn_s_setprio(1); _Pragma("unroll") for (int m = 0; m < 4; ++m) _Pragma("unroll") for (int n = 0; n < 2; ++n) _Pragma("unroll") for (int k = 0; k < 2; ++k) \
        acc[ai][bj][m][n] = __builtin_amdgcn_mfma_f32_16x16x32_bf16(Bt[n][k], At[m][k], acc[ai][bj][m][n], 0, 0, 0); __builtin_amdgcn_s_setprio(0); } while (0)
#define PG8_WAIT_V(n) asm volatile("s_waitcnt vmcnt(" #n ")" ::: "memory")
#define PG8_WAIT_V8B asm volatile("s_waitcnt vmcnt(%1)\n\ts_cmp_eq_u32 %0, 0\n\ts_cbranch_scc1 1f\n\ts_waitcnt vmcnt(8)\n1:" :: "s"(strict), "n"(8 + Epi::NEP) : "memory", "scc")
#define PG8_WAIT_L(n) asm volatile("s_waitcnt lgkmcnt(" #n ")" ::: "memory")
#define PG8_BAR __builtin_amdgcn_s_barrier()
#define PG8_SCHED __builtin_amdgcn_sched_barrier(0)
    Unit cur, nxt; int ui = 0;
    if (!S.next(0, cur)) return;
    f32x4 acc[2][2][4][2];
#pragma unroll
    for (int a = 0; a < 2; ++a)
#pragma unroll
        for (int b = 0; b < 2; ++b)
#pragma unroll
            for (int m = 0; m < 4; ++m)
#pragma unroll
                for (int n = 0; n < 2; ++n) acc[a][b][m][n] = (f32x4){0.f, 0.f, 0.f, 0.f};
    bf16x8 At[4][2], B0[2][2], B1[2][2];
    const char* cA = (const char*)g.A + (size_t)cur.pm * tstep; const char* cB = (const char*)g.Bt + (size_t)cur.pn * tstep;
    S.a_ready(cur);
    if constexpr (SP2) {
        PG8_STAGE(PG8_SB(0, 0), cB, voffB); PG8_STAGE(PG8_SB(0, 1), cB + hstep, voffB); PG8_STAGE(PG8_SA(0, 0), cA, voffA); PG8_STAGE(PG8_SA(0, 1), cA + hstep, voffA);
        if (wr == 1) PG8_BAR;
        PG8_WAIT_V(2); PG8_BAR;
        PG8_STAGE(PG8_SB(1, 0), cB + kstep, voffB); PG8_STAGE(PG8_SA(1, 0), cA + kstep, voffA); PG8_STAGE(PG8_SB(1, 1), cB + hstep + kstep, voffB);
        PG8_WAIT_V(6); PG8_BAR;
    } else {
        PG8_STAGE(PG8_SB(0, 0), cB, voffB); PG8_STAGE(PG8_SA(0, 0), cA, voffA); PG8_STAGE(PG8_SB(0, 1), cB + hstep, voffB); PG8_STAGE(PG8_SA(0, 1), cA + hstep, voffA);
        if (wr == 1) PG8_BAR;
        PG8_WAIT_V(4); PG8_BAR;
        PG8_STAGE(PG8_SB(1, 0), cB + kstep, voffB); PG8_STAGE(PG8_SA(1, 0), cA + kstep, voffA); PG8_STAGE(PG8_SB(1, 1), cB + hstep + kstep, voffB);
        PG8_WAIT_V(6); PG8_BAR;
    }
    for (;;) {
        const bool has_next = S.next(ui + 1, nxt);
        const char* nA = has_next ? (const char*)g.A + (size_t)nxt.pm * tstep : cA; const char* nB = has_next ? (const char*)g.Bt + (size_t)nxt.pn * tstep : cB;
        for (int t = 0; t < nt; t += 2) {
            const bool last = (t == nt - 2);
            const char* a1 = cA + (size_t)(t + 1) * kstep;
            const char* a2 = last ? nA : cA + (size_t)(t + 2) * kstep; const char* b2 = last ? nB : cB + (size_t)(t + 2) * kstep;
            const char* a3 = a2 + kstep; const char* b3 = b2 + kstep;
            if (last && has_next) S.a_ready(nxt);
            const int strict = __builtin_amdgcn_readfirstlane((t == 0 && ui > 0) ? 0 : 1);
            if constexpr (SP2) {
            PG8_LDB(B0, 0, 0); PG8_LDB(B1, 0, 1); PG8_SCHED; PG8_LDA(At, 0, 0); PG8_STAGE(PG8_SA(1, 1), a1 + hstep, voffA);
            PG8_WAIT_V8B; PG8_WAIT_L(0); PG8_BAR; PG8_MMA(0, 0, At, B0); PG8_MMA(0, 1, At, B1); PG8_BAR; PG8_SCHED;
            PG8_LDA(At, 0, 1); PG8_STAGE(PG8_SB(0, 0), b2, voffB); PG8_STAGE(PG8_SB(0, 1), b2 + hstep, voffB); PG8_STAGE(PG8_SA(0, 0), a2, voffA);
            PG8_WAIT_V8B; PG8_WAIT_L(0); PG8_BAR; PG8_MMA(1, 0, At, B0); PG8_MMA(1, 1, At, B1); PG8_BAR; PG8_SCHED;
            PG8_LDB(B0, 1, 0); PG8_LDB(B1, 1, 1); PG8_SCHED; PG8_LDA(At, 1, 0); PG8_STAGE(PG8_SA(0, 1), a2 + hstep, voffA);
            PG8_WAIT_V(8); PG8_WAIT_L(0); PG8_BAR; PG8_MMA(0, 0, At, B0); PG8_MMA(0, 1, At, B1); PG8_BAR; PG8_SCHED;
            PG8_LDA(At, 1, 1); PG8_STAGE(PG8_SB(1, 0), b3, voffB); PG8_STAGE(PG8_SB(1, 1), b3 + hstep, voffB); PG8_STAGE(PG8_SA(1, 0), a3, voffA);
            PG8_WAIT_V(8); PG8_WAIT_L(0); PG8_BAR; PG8_MMA(1, 0, At, B0); PG8_MMA(1, 1, At, B1); PG8_BAR; PG8_SCHED;
            } else {
            PG8_LDB(B0, 0, 0); PG8_SCHED; PG8_LDA(At, 0, 0); PG8_STAGE(PG8_SA(1, 1), a1 + hstep, voffA);
            PG8_WAIT_L(8); PG8_BAR; PG8_WAIT_L(0); PG8_MMA(0, 0, At, B0); PG8_BAR; PG8_SCHED;
            PG8_LDB(B1, 0, 1); PG8_STAGE(PG8_SB(0, 0), b2, voffB);
            PG8_BAR; PG8_WAIT_L(0); PG8_MMA(0, 1, At, B1); PG8_BAR;
            PG8_LDA(At, 0, 1); PG8_STAGE(PG8_SA(0, 0), a2, voffA);
            PG8_BAR; PG8_WAIT_L(0); PG8_MMA(1, 0, At, B0); PG8_BAR; PG8_SCHED;
            PG8_STAGE(PG8_SB(0, 1), b2 + hstep, voffB);
            PG8_WAIT_V(6); PG8_BAR; PG8_MMA(1, 1, At, B1); PG8_BAR;
            PG8_LDB(B0, 1, 0); PG8_SCHED; PG8_LDA(At, 1, 0); PG8_STAGE(PG8_SA(0, 1), a2 + hstep, voffA);
            PG8_WAIT_L(8); PG8_BAR; PG8_WAIT_L(0); PG8_MMA(0, 0, At, B0); PG8_BAR; PG8_SCHED;
            PG8_LDB(B1, 1, 1); PG8_STAGE(PG8_SB(1, 0), b3, voffB);
            PG8_BAR; PG8_WAIT_L(0); PG8_MMA(0, 1, At, B1); PG8_BAR;
            PG8_LDA(At, 1, 1); PG8_STAGE(PG8_SA(1, 0), a3, voffA);
            PG8_BAR; PG8_WAIT_L(0); PG8_MMA(1, 0, At, B0); PG8_BAR; PG8_SCHED;
            PG8_STAGE(PG8_SB(1, 1), b3 + hstep, voffB);
            PG8_WAIT_V(6); PG8_BAR; PG8_MMA(1, 1, At, B1); PG8_BAR;
            }
        }
        if constexpr (ALIGN_EPI) { if (wr == 0) PG8_BAR; }
        if constexpr (!Epi::AFTER_DRAIN) { E(acc, cur, wr, wc, fr, fq); S.done(cur); }
        if (!has_next) break;
#pragma unroll
        for (int a = 0; a < 2; ++a)
#pragma unroll
            for (int b = 0; b < 2; ++b)
#pragma unroll
                for (int m = 0; m < 4; ++m)
#pragma unroll
                    for (int n = 0; n < 2; ++n) acc[a][b][m][n] = (f32x4){0.f, 0.f, 0.f, 0.f};
        cur = nxt; cA = nA; cB = nB; ++ui;
        if constexpr (ALIGN_EPI) { if (wr == 1) PG8_BAR; }
    }
    PG8_WAIT_V(0);
    if constexpr (!ALIGN_EPI) { if (wr == 0) PG8_BAR; }
    PG8_BAR;
    if constexpr (Epi::AFTER_DRAIN) { E.fused(acc, cur, wr, wc, fr, fq, lds, wid, lane); S.done(cur); }
#undef PG8_SA
#undef PG8_SB
#undef PG8_STAGE
#undef PG8_LDA
#undef PG8_LDB
#undef PG8_MMA
#undef PG8_WAIT_V
#undef PG8_WAIT_V8B
#undef PG8_WAIT_L
#undef PG8_BAR
#undef PG8_SCHED
}
}
using pg8::bf16_t; using pg8::bf16x8; using pg8::f32x4; using pg8::u32x4; using pg8::u32x2; using pg8::cvt_pk_bf16; using pg8::xswz; using pg8::xswzu; using pg8::sum_x32; using pg8::max_x32; using pg8::or_x32; using pg8::sum_g; using pg8::max_g;
#define LAS __attribute__((address_space(3)))
typedef LAS unsigned char* ldsp;
typedef short s16x4 __attribute__((ext_vector_type(4)));
typedef short v4i16_t __attribute__((ext_vector_type(4)));
__device__ __forceinline__ bf16x8 lds_rd16(ldsp p) { return *(const LAS bf16x8*)p; }
__device__ __forceinline__ s16x4 lds_tr(ldsp p) { return __builtin_bit_cast(s16x4, __builtin_amdgcn_ds_read_tr16_b64_v4i16((LAS v4i16_t*)p)); }
__device__ __forceinline__ bf16x8 cat4(s16x4 a, s16x4 b) { return (bf16x8){a[0], a[1], a[2], a[3], b[0], b[1], b[2], b[3]}; }
__device__ __forceinline__ bf16x8 pack8(const f32x4& a, const f32x4& b) {
    u32x4 w; w.x = cvt_pk_bf16(a[0], a[1]); w.y = cvt_pk_bf16(a[2], a[3]); w.z = cvt_pk_bf16(b[0], b[1]); w.w = cvt_pk_bf16(b[2], b[3]); return __builtin_bit_cast(bf16x8, w); }
__device__ __forceinline__ float bflo(unsigned w) { return __uint_as_float(w << 16); }
__device__ __forceinline__ float bfhi(unsigned w) { return __uint_as_float(w & 0xffff0000u); }
#define MFMA16(a, b, c) __builtin_amdgcn_mfma_f32_16x16x32_bf16((a), (b), (c), 0, 0, 0)
constexpr int P64 = 144, P128 = 272;
constexpr int LDP = 3072;
constexpr float C2 = 0.125f * 1.4426950408889634f;
constexpr float NEGB = -1e30f;

__device__ __forceinline__ float ret_log2g(int h) { return __log2f(1.0f - exp2f(-5.0f - (float)h)); }

template <int NIT> __device__ __forceinline__ void stage64(ldsp dst, const bf16_t* src, size_t ld, int rows, int tid) {
    u32x4 v[NIT];
#pragma unroll
    for (int i = 0; i < NIT; ++i) { const int idx = tid + 512 * i, r = idx >> 3, ch = idx & 7; if (idx < rows * 8) v[i] = *(const u32x4*)(src + (size_t)r * ld + ch * 8); }
#pragma unroll
    for (int i = 0; i < NIT; ++i) { const int idx = tid + 512 * i, r = idx >> 3, ch = idx & 7; if (idx < rows * 8) *(LAS u32x4*)(dst + r * P64 + ch * 16) = v[i]; }
}
template <int NIT> __device__ __forceinline__ void stage128(ldsp dst, const bf16_t* src, size_t ld, int rows, int tid) {
    u32x4 v[NIT];
#pragma unroll
    for (int i = 0; i < NIT; ++i) { const int idx = tid + 512 * i, r = idx >> 4, ch = idx & 15; if (idx < rows * 16) v[i] = *(const u32x4*)(src + (size_t)r * ld + ch * 8); }
#pragma unroll
    for (int i = 0; i < NIT; ++i) { const int idx = tid + 512 * i, r = idx >> 4, ch = idx & 15; if (idx < rows * 16) *(LAS u32x4*)(dst + r * P128 + ch * 16) = v[i]; }
}

__device__ __forceinline__ void ret_u_unit(ldsp lds, int unit, const bf16_t* P, float* ST) {
    int tid = threadIdx.x; asm volatile("" : "+v"(tid)); const int lane = tid & 63, w = __builtin_amdgcn_readfirstlane(tid >> 6), j = lane & 15, g = lane >> 4, r4 = j >> 2, cc = lane & 3;
    const int c = unit & 31, h = (unit >> 5) & 3, b = unit >> 7;
    const size_t row0 = (size_t)b * 4096 + c * 128;
    const float l2g = ret_log2g(h);
    const ldsp RK = lds, RV = lds + 18432;
    u32x4 kv[2];
#pragma unroll
    for (int i = 0; i < 2; ++i) { const int idx = tid + 512 * i, r = idx >> 3, ch = idx & 7; kv[i] = *(const u32x4*)(P + (row0 + r) * LDP + 256 + h * 64 + ch * 8); }
    stage128<4>(RV, P + row0 * LDP + 512 + h * 128, LDP, 128, tid);
#pragma unroll
    for (int i = 0; i < 2; ++i) { const int idx = tid + 512 * i, r = idx >> 3, ch = idx & 7; const u32x4 v = kv[i];
        const float z = exp2f((float)(127 - r) * l2g); u32x4 o;
        o.x = cvt_pk_bf16(bflo(v.x) * z, bfhi(v.x) * z); o.y = cvt_pk_bf16(bflo(v.y) * z, bfhi(v.y) * z); o.z = cvt_pk_bf16(bflo(v.z) * z, bfhi(v.z) * z); o.w = cvt_pk_bf16(bflo(v.w) * z, bfhi(v.w) * z);
        *(LAS u32x4*)(RK + r * P64 + ch * 16) = o; }
    __syncthreads();
    f32x4 acc[4];
#pragma unroll
    for (int dt = 0; dt < 4; ++dt) acc[dt] = (f32x4){0.f, 0.f, 0.f, 0.f};
#pragma unroll
    for (int ks = 0; ks < 4; ++ks) {
        const int tr0 = 32 * ks + 8 * g + r4;
        const bf16x8 vf = cat4(lds_tr(RV + tr0 * P128 + (16 * w + 4 * cc) * 2), lds_tr(RV + (tr0 + 4) * P128 + (16 * w + 4 * cc) * 2));
#pragma unroll
        for (int dt = 0; dt < 4; ++dt) {
            const bf16x8 kf = cat4(lds_tr(RK + tr0 * P64 + (16 * dt + 4 * cc) * 2), lds_tr(RK + (tr0 + 4) * P64 + (16 * dt + 4 * cc) * 2));
            acc[dt] = MFMA16(kf, vf, acc[dt]);
        }
    }
    float* U = ST + (size_t)unit * 8192;
#pragma unroll
    for (int dt = 0; dt < 4; ++dt)
#pragma unroll
        for (int e = 0; e < 4; ++e) U[(16 * dt + 4 * g + e) * 128 + 16 * w + j] = acc[dt][e];
    __syncthreads();
}

__device__ __forceinline__ void ret_out_unit(ldsp lds, int unit, const bf16_t* P, const float* ST, const float* gnw, bf16_t* MIX) {
    int tid = threadIdx.x; asm volatile("" : "+v"(tid)); const int lane = tid & 63, w = __builtin_amdgcn_readfirstlane(tid >> 6), j = lane & 15, g = lane >> 4, r4 = j >> 2, cc = lane & 3;
    const int c = unit & 31, h = (unit >> 5) & 3, b = unit >> 7;
    const size_t row0 = (size_t)b * 4096 + c * 128;
    const float l2g = ret_log2g(h);
    const ldsp OQ = lds, OK = lds + 18432, OV = lds + 36864, OS = lds + 71680;
    {
      u32x4 vq[2], vk[2], vv[4]; f32x4 vs[4];
      const float* S = ST + (size_t)unit * 8192;
#pragma unroll
      for (int i = 0; i < 2; ++i) { const int idx = tid + 512 * i, r = idx >> 3, ch = idx & 7; vq[i] = *(const u32x4*)(P + (row0 + r) * LDP + h * 64 + ch * 8); vk[i] = *(const u32x4*)(P + (row0 + r) * LDP + 256 + h * 64 + ch * 8); }
#pragma unroll
      for (int i = 0; i < 4; ++i) { const int idx = tid + 512 * i, r = idx >> 4, ch = idx & 15; vv[i] = *(const u32x4*)(P + (row0 + r) * LDP + 512 + h * 128 + ch * 8); }
#pragma unroll
      for (int k = 0; k < 4; ++k) { const int idx = tid + 512 * k, d = idx >> 5, e4 = idx & 31; vs[k] = *(const f32x4*)(S + d * 128 + 4 * e4); }
#pragma unroll
      for (int i = 0; i < 2; ++i) { const int idx = tid + 512 * i, r = idx >> 3, ch = idx & 7; *(LAS u32x4*)(OQ + r * P64 + ch * 16) = vq[i]; *(LAS u32x4*)(OK + r * P64 + ch * 16) = vk[i]; }
#pragma unroll
      for (int i = 0; i < 4; ++i) { const int idx = tid + 512 * i, r = idx >> 4, ch = idx & 15; *(LAS u32x4*)(OV + r * P128 + ch * 16) = vv[i]; }
#pragma unroll
      for (int k = 0; k < 4; ++k) { const int idx = tid + 512 * k, d = idx >> 5, e4 = idx & 31; u32x2 o; o.x = cvt_pk_bf16(vs[k][0], vs[k][1]); o.y = cvt_pk_bf16(vs[k][2], vs[k][3]); *(LAS u32x2*)(OS + d * P128 + e4 * 8) = o; }
    }
    __syncthreads();
    bf16x8 qf[2];
#pragma unroll
    for (int s = 0; s < 2; ++s) qf[s] = lds_rd16(OQ + (16 * w + j) * P64 + 64 * s + 16 * g);
    f32x4 tot[8];
#pragma unroll
    for (int et = 0; et < 8; ++et) tot[et] = (f32x4){0.f, 0.f, 0.f, 0.f};
#pragma unroll
    for (int ks = 0; ks < 2; ++ks) {
        const int tr0 = 32 * ks + 8 * g + r4;
#pragma unroll
        for (int et = 0; et < 8; ++et) {
            const bf16x8 sf = cat4(lds_tr(OS + tr0 * P128 + (16 * et + 4 * cc) * 2), lds_tr(OS + (tr0 + 4) * P128 + (16 * et + 4 * cc) * 2));
            tot[et] = MFMA16(sf, qf[ks], tot[et]);
        }
    }
    const int n = 16 * w + j;
    { const float xi = exp2f((float)(n + 1) * l2g);
#pragma unroll
      for (int et = 0; et < 8; ++et) tot[et] = tot[et] * xi; }
#pragma unroll
    for (int u = 0; u < 4; ++u) {
        if (2 * u <= w) {
            f32x4 s0 = (f32x4){0.f, 0.f, 0.f, 0.f}, s1 = (f32x4){0.f, 0.f, 0.f, 0.f};
#pragma unroll
            for (int s = 0; s < 2; ++s) {
                s0 = MFMA16(lds_rd16(OK + (32 * u + j) * P64 + 64 * s + 16 * g), qf[s], s0);
                s1 = MFMA16(lds_rd16(OK + (32 * u + 16 + j) * P64 + 64 * s + 16 * g), qf[s], s1);
            }
#pragma unroll
            for (int e = 0; e < 4; ++e) { const int d0 = n - (32 * u + 4 * g + e), d1 = d0 - 16;
                s0[e] = d0 >= 0 ? s0[e] * exp2f((float)d0 * l2g) : 0.f; s1[e] = d1 >= 0 ? s1[e] * exp2f((float)d1 * l2g) : 0.f; }
            const bf16x8 pf = pack8(s0, s1);
            const int tr0 = 32 * u + 4 * g + r4;
#pragma unroll
            for (int et = 0; et < 8; ++et) {
                const bf16x8 vf = cat4(lds_tr(OV + tr0 * P128 + (16 * et + 4 * cc) * 2), lds_tr(OV + (tr0 + 16) * P128 + (16 * et + 4 * cc) * 2));
                tot[et] = MFMA16(vf, pf, tot[et]);
            }
        }
    }
    float s1 = 0.f;
#pragma unroll
    for (int et = 0; et < 8; ++et) s1 += (tot[et][0] + tot[et][1]) + (tot[et][2] + tot[et][3]);
    s1 = sum_g(s1);
    const float mu = s1 * (1.0f / 128.0f); float s2 = 0.f;
#pragma unroll
    for (int et = 0; et < 8; ++et) { tot[et] = tot[et] - mu; s2 += (tot[et][0] * tot[et][0] + tot[et][1] * tot[et][1]) + (tot[et][2] * tot[et][2] + tot[et][3] * tot[et][3]); }
    s2 = sum_g(s2);
    const float rs = __builtin_amdgcn_rsqf(s2 * (1.0f / 128.0f) + 1e-5f);
    const size_t row = row0 + n;
    f32x4 gwv[8]; u32x2 rgw[8];
#pragma unroll
    for (int et = 0; et < 8; ++et) { const int e0 = h * 128 + 16 * et + 4 * g; gwv[et] = *(const f32x4*)(gnw + e0); rgw[et] = *(const u32x2*)(P + row * LDP + 1024 + e0); }
#pragma unroll
    for (int et = 0; et < 8; ++et) {
        const int e0 = h * 128 + 16 * et + 4 * g;
        const f32x4 gw = gwv[et]; const u32x2 rgv = rgw[et];
        const float r0 = bflo(rgv.x), r1 = bfhi(rgv.x), r2 = bflo(rgv.y), r3 = bfhi(rgv.y);
        const float o0 = tot[et][0] * rs * gw[0] * pg8::silu_f(r0), o1 = tot[et][1] * rs * gw[1] * pg8::silu_f(r1);
        const float o2 = tot[et][2] * rs * gw[2] * pg8::silu_f(r2), o3 = tot[et][3] * rs * gw[3] * pg8::silu_f(r3);
        u32x2 o; o.x = cvt_pk_bf16(o0, o1); o.y = cvt_pk_bf16(o2, o3);
        __builtin_nontemporal_store(o, (u32x2*)(MIX + row * 1024 + e0));
    }
    __syncthreads();
}

__device__ __forceinline__ float gelu_tanh(float x) {
    const float y = 0.7978845608028654f * (x + 0.044715f * x * x * x);
    const float e = __expf(2.0f * y);
    const float th = 1.0f - 2.0f * __builtin_amdgcn_rcpf(e + 1.0f);
    return 0.5f * x * (1.0f + th);
}
__device__ __forceinline__ void cmp_unit(ldsp lds, int unit, const bf16_t* P, const bf16_t* PEb, const bf16_t* W1t, const float* b1, const bf16_t* W2t, bf16_t* OUT, int srccol) {
    int tid = threadIdx.x; asm volatile("" : "+v"(tid)); const int lane = tid & 63, w = __builtin_amdgcn_readfirstlane(tid >> 6), j = lane & 15, g = lane >> 4;
    const int ct = unit & 7, grp = (unit >> 3) & 1, b = unit >> 4;
    const ldsp CS = lds, CP = lds + 76032, CH = lds + 80640;
    const size_t rowb = (size_t)b * 4096;
    { u32x4 sv[9];
#pragma unroll
      for (int i = 0; i < 9; ++i) { const int idx = tid + 512 * i, tt = idx >> 3, ch = idx & 7, tok = 512 * ct + tt;
          sv[i] = (u32x4){0u, 0u, 0u, 0u}; if (idx < 528 * 8 && tok < 4096) sv[i] = *(const u32x4*)(P + (rowb + tok) * LDP + srccol + grp * 64 + ch * 8); }
#pragma unroll
      for (int i = 0; i < 9; ++i) { const int idx = tid + 512 * i, tt = idx >> 3, ch = idx & 7;
          if (idx < 528 * 8) *(LAS u32x4*)(CS + ((tt & 15) * 33 + (tt >> 4)) * P64 + ch * 16) = sv[i]; } }
    if (tid < 256) { const int l = tid >> 3, ch = tid & 7; *(LAS u32x4*)(CP + l * P64 + ch * 16) = *(const u32x4*)(PEb + (l * 2 + grp) * 64 + ch * 8); }
    __syncthreads();
    f32x4 acc[2][3];
#pragma unroll
    for (int a = 0; a < 2; ++a)
#pragma unroll
        for (int m = 0; m < 3; ++m) acc[a][m] = (f32x4){0.f, 0.f, 0.f, 0.f};
    const bf16_t* wrow0 = W1t + (size_t)(32 * w + j) * 2048 + 8 * g;
    const bf16_t* wrow1 = wrow0 + 16 * 2048;
    const bf16x8 zf = (bf16x8){0, 0, 0, 0, 0, 0, 0, 0};
#pragma unroll 8
    for (int l = 0; l < 32; ++l) {
#pragma unroll
        for (int s = 0; s < 2; ++s) {
            const bf16x8 w0 = *(const bf16x8*)(wrow0 + 64 * l + 32 * s), w1 = *(const bf16x8*)(wrow1 + 64 * l + 32 * s);
            const int rb = (l & 15) * 33 + (l >> 4) + j;
            const bf16x8 a0 = lds_rd16(CS + rb * P64 + 64 * s + 16 * g), a1 = lds_rd16(CS + (rb + 16) * P64 + 64 * s + 16 * g);
            bf16x8 pf = lds_rd16(CP + l * P64 + 64 * s + 16 * g); pf = (j == 0) ? pf : zf;
            acc[0][0] = MFMA16(w0, a0, acc[0][0]); acc[0][1] = MFMA16(w0, a1, acc[0][1]); acc[0][2] = MFMA16(w0, pf, acc[0][2]);
            acc[1][0] = MFMA16(w1, a0, acc[1][0]); acc[1][1] = MFMA16(w1, a1, acc[1][1]); acc[1][2] = MFMA16(w1, pf, acc[1][2]);
        }
    }
#pragma unroll
    for (int a = 0; a < 2; ++a) {
        const f32x4 bb = *(const f32x4*)(b1 + 32 * w + 16 * a + 4 * g);
        f32x4 bv;
#pragma unroll
        for (int e = 0; e < 4; ++e) bv[e] = __shfl(acc[a][2][e], lane & 48) + bb[e];
#pragma unroll
        for (int m = 0; m < 2; ++m) {
            const f32x4 x = acc[a][m] + bv;
            u32x2 o; o.x = cvt_pk_bf16(gelu_tanh(x[0]), gelu_tanh(x[1])); o.y = cvt_pk_bf16(gelu_tanh(x[2]), gelu_tanh(x[3]));
            *(LAS u32x2*)(CH + (16 * m + j) * 528 + (32 * w + 16 * a + 4 * g) * 2) = o;
        }
    }
    __syncthreads();
    { const int mt = w >> 2, dt = w & 3; f32x4 a2 = (f32x4){0.f, 0.f, 0.f, 0.f};
#pragma unroll
      for (int ks = 0; ks < 8; ++ks) {
          const bf16x8 wf = *(const bf16x8*)(W2t + (size_t)(16 * dt + j) * 256 + 32 * ks + 8 * g);
          const bf16x8 hf = lds_rd16(CH + (16 * mt + j) * 528 + (32 * ks + 8 * g) * 2);
          a2 = MFMA16(wf, hf, a2);
      }
      const int cidx = 32 * ct + 16 * mt + j;
      u32x2 o; o.x = cvt_pk_bf16(a2[0], a2[1]); o.y = cvt_pk_bf16(a2[2], a2[3]);
      *(u32x2*)(OUT + ((size_t)(b * 2 + grp) * 256 + cidx) * 64 + 16 * dt + 4 * g) = o; }
    __syncthreads();
}

constexpr int NS_KC = 0, NS_VC = 36864, NS_KB = 73728, NS_VB = 92160, NS_IMP = 110592, NS_UNI = 127232;
#define EX2(x) __builtin_amdgcn_exp2f(x)
template <int MODE> __device__ __forceinline__ void nsa_block(ldsp KB, ldsp VB, const bf16x8 (&q)[2][2], f32x4 (&o)[2][4], f32x4 (&lacc)[2], float (&mref)[2], bool first, int jb, int qi, int tl, bool rowsel, int j, int g, int r4, int cc) {
    f32x4 S[2][4];
    {
        bf16x8 kf[4][2];
#pragma unroll
        for (int kt = 0; kt < 4; ++kt)
#pragma unroll
            for (int s = 0; s < 2; ++s) kf[kt][s] = lds_rd16(KB + (16 * kt + j) * P64 + 64 * s + 16 * g);
        __builtin_amdgcn_s_setprio(1);
        const f32x4 z4 = (f32x4){0.f, 0.f, 0.f, 0.f};
#pragma unroll
        for (int qt = 0; qt < 2; ++qt)
#pragma unroll
            for (int kt = 0; kt < 4; ++kt) { f32x4 a = MFMA16(kf[kt][0], q[qt][0], z4); a = MFMA16(kf[kt][1], q[qt][1], a); S[qt][kt] = a; }
        __builtin_amdgcn_s_setprio(0);
    }
    if (__any(mref[0] != 0.f || mref[1] != 0.f)) {
#pragma unroll
        for (int qt = 0; qt < 2; ++qt)
#pragma unroll
            for (int kt = 0; kt < 4; ++kt) S[qt][kt] = S[qt][kt] - mref[qt];
    }
    if (jb == qi) {
#pragma unroll
        for (int qt = 0; qt < 2; ++qt)
#pragma unroll
            for (int kt = 0; kt < 4; ++kt)
#pragma unroll
                for (int e = 0; e < 4; ++e) S[qt][kt][e] = (16 * kt + 4 * g + e <= tl) ? S[qt][kt][e] : NEGB;
    }
    if (MODE == 1 && jb == qi - 8) {
#pragma unroll
        for (int qt = 0; qt < 2; ++qt)
#pragma unroll
            for (int kt = 0; kt < 4; ++kt)
#pragma unroll
                for (int e = 0; e < 4; ++e) S[qt][kt][e] = (16 * kt + 4 * g + e > tl) ? S[qt][kt][e] : NEGB;
    }
    float mx[2];
#pragma unroll
    for (int qt = 0; qt < 2; ++qt) {
        float m0 = __builtin_fmaxf(S[qt][0][0], S[qt][0][1]);
        float m1 = __builtin_fmaxf(S[qt][0][2], S[qt][0][3]);
#pragma unroll
        for (int kt = 1; kt < 4; ++kt) { m0 = __builtin_fmaxf(__builtin_fmaxf(m0, S[qt][kt][0]), S[qt][kt][1]); m1 = __builtin_fmaxf(__builtin_fmaxf(m1, S[qt][kt][2]), S[qt][kt][3]); }
        m0 = __builtin_fmaxf(m0, m1);
        if (MODE == 0) m0 = rowsel ? m0 : NEGB;
        mx[qt] = max_g(m0);
    }
    if (__any(fmaxf(mx[0], mx[1]) > 8.0f)) {
#pragma unroll
        for (int qt = 0; qt < 2; ++qt) {
            const float d = fmaxf(mx[qt], 0.f);
            const float alpha = EX2(-d); mref[qt] += d;
#pragma unroll
            for (int kt = 0; kt < 4; ++kt) S[qt][kt] = S[qt][kt] - d;
#pragma unroll
            for (int dt = 0; dt < 4; ++dt) o[qt][dt] = o[qt][dt] * alpha;
            lacc[qt] = lacc[qt] * alpha;
        }
    }
    __builtin_amdgcn_sched_barrier(0);
    bf16x8 vf[2][4];
#pragma unroll
    for (int u = 0; u < 2; ++u) { const int tr0 = 32 * u + 4 * g + r4;
#pragma unroll
        for (int dt = 0; dt < 4; ++dt) vf[u][dt] = cat4(lds_tr(VB + tr0 * P64 + (16 * dt + 4 * cc) * 2), lds_tr(VB + (tr0 + 16) * P64 + (16 * dt + 4 * cc) * 2)); }
    const short one = 0x3F80; const bf16x8 ones = (bf16x8){one, one, one, one, one, one, one, one};
#pragma unroll
    for (int qt = 0; qt < 2; ++qt) {
#pragma unroll
        for (int kt = 0; kt < 4; ++kt)
#pragma unroll
            for (int e = 0; e < 4; ++e) S[qt][kt][e] = EX2(S[qt][kt][e]);
#pragma unroll
        for (int u = 0; u < 2; ++u) {
            bf16x8 p = pack8(S[qt][2 * u], S[qt][2 * u + 1]);
            if (MODE == 0) { const bf16x8 z = (bf16x8){0, 0, 0, 0, 0, 0, 0, 0}; p = rowsel ? p : z; }
#pragma unroll
            for (int dt = 0; dt < 4; ++dt) o[qt][dt] = MFMA16(vf[u][dt], p, o[qt][dt]);
            lacc[qt] = MFMA16(ones, p, lacc[qt]);
        }
    }
    __builtin_amdgcn_sched_group_barrier(0x100, 16, 0);
    __builtin_amdgcn_sched_group_barrier(0x400, 16, 0);
    __builtin_amdgcn_sched_group_barrier(0x002, 12, 0);
#pragma unroll
    for (int i = 0; i < 10; ++i) { __builtin_amdgcn_sched_group_barrier(0x008, 1, 0); __builtin_amdgcn_sched_group_barrier(0x400, 2, 0); __builtin_amdgcn_sched_group_barrier(0x002, 2, 0); }
    __builtin_amdgcn_sched_group_barrier(0x008, 10, 0);
    __builtin_amdgcn_sched_barrier(0);
}

template <int MODE> __device__ __forceinline__ void nsa_branch(ldsp lds, const bf16_t* Kg, const bf16_t* Vg, const bf16x8 (&q)[2][2], f32x4 (&ofin)[2][4], const float (&gate)[2],
                                                               int qi, int tl, unsigned long long selm, unsigned long long unim, int jb0, int tid, int j, int g, int r4, int cc) {
    f32x4 o[2][4], lacc[2]; float mref[2] = {0.f, 0.f};
#pragma unroll
    for (int qt = 0; qt < 2; ++qt) { lacc[qt] = (f32x4){0.f, 0.f, 0.f, 0.f};
#pragma unroll
        for (int dt = 0; dt < 4; ++dt) o[qt][dt] = (f32x4){0.f, 0.f, 0.f, 0.f}; }
    const int kr = tid >> 3, kc8 = (tid & 7) * 8;
#define NXT(x) do { ++(x); while ((x) <= qi && !((unim >> (x)) & 1ull)) ++(x); } while (0)
#define LDKV(kd, vd, jj) do { if ((jj) <= qi) { kd = *(const u32x4*)(Kg + (size_t)(64 * (jj) + kr) * LDP + kc8); vd = *(const u32x4*)(Vg + (size_t)(64 * (jj) + kr) * LDP + kc8); } } while (0)
    int jb = jb0 - 1; NXT(jb);
    int jn = jb; NXT(jn);
    u32x4 k0 = (u32x4){0u, 0u, 0u, 0u}, v0 = k0, k1 = k0, v1 = k0;
    LDKV(k0, v0, jb); LDKV(k1, v1, jn);
    int buf = 0; bool first = true;
    while (jb <= qi) {
        const ldsp KB = lds + NS_KB + buf * 9216, VB = lds + NS_VB + buf * 9216;
        *(LAS u32x4*)(KB + kr * P64 + kc8 * 2) = k0; *(LAS u32x4*)(VB + kr * P64 + kc8 * 2) = v0;
        __syncthreads();
        int jnn = jn; NXT(jnn);
        k0 = k1; v0 = v1; LDKV(k1, v1, jnn);
        const bool rowsel = (MODE == 1) ? true : (((selm >> jb) & 1ull) != 0ull);
        nsa_block<MODE>(KB, VB, q, o, lacc, mref, first, jb, qi, tl, rowsel, j, g, r4, cc);
        jb = jn; jn = jnn; buf ^= 1; first = false;
    }
#undef NXT
#undef LDKV
#pragma unroll
    for (int qt = 0; qt < 2; ++qt) {
        const float ls = lacc[qt][0];
        const float sc = ls > 0.f ? gate[qt] / ls : 0.f;
#pragma unroll
        for (int dt = 0; dt < 4; ++dt) ofin[qt][dt] += o[qt][dt] * sc;
    }
    __syncthreads();
}

__device__ __forceinline__ bf16x8 scale8(bf16x8 v, float f) {
    const u32x4 w = __builtin_bit_cast(u32x4, v); u32x4 o;
    o.x = cvt_pk_bf16(bflo(w.x) * f, bfhi(w.x) * f); o.y = cvt_pk_bf16(bflo(w.y) * f, bfhi(w.y) * f); o.z = cvt_pk_bf16(bflo(w.z) * f, bfhi(w.z) * f); o.w = cvt_pk_bf16(bflo(w.w) * f, bfhi(w.w) * f);
    return __builtin_bit_cast(bf16x8, o);
}

__device__ __forceinline__ float sigmoid_f(float x) { return __builtin_amdgcn_rcpf(1.0f + __expf(-x)); }

__device__ __forceinline__ void nsa_unit(ldsp lds, int b, int grp, int qi, const bf16_t* P, const bf16_t* QR, const bf16_t* KCMP, const bf16_t* VCMP, bf16_t* MIX) {
    int tid = threadIdx.x; asm volatile("" : "+v"(tid)); const int lane = tid & 63, w = __builtin_amdgcn_readfirstlane(tid >> 6), j = lane & 15, g = lane >> 4, r4 = j >> 2, cc = lane & 3;
    const size_t rowbase = (size_t)b * 4096;
    const int nu = (((4 * qi + 3 + 15) >> 4) + 1) >> 1;
    { const bf16_t* kc = KCMP + (size_t)(b * 2 + grp) * 256 * 64; const bf16_t* vc = VCMP + (size_t)(b * 2 + grp) * 256 * 64;
      u32x4 ck[4], cv[4];
#pragma unroll
      for (int i = 0; i < 4; ++i) { const int idx = tid + 512 * i; if (idx < 32 * nu * 8) { ck[i] = *(const u32x4*)(kc + (size_t)idx * 8); cv[i] = *(const u32x4*)(vc + (size_t)idx * 8); } }
#pragma unroll
      for (int i = 0; i < 4; ++i) { const int idx = tid + 512 * i, r = idx >> 3, ch = idx & 7; if (idx < 32 * nu * 8) { *(LAS u32x4*)(lds + NS_KC + r * P64 + ch * 16) = ck[i]; *(LAS u32x4*)(lds + NS_VC + r * P64 + ch * 16) = cv[i]; } } }
    const int tl = 8 * w + (j & 7), t = qi * 64 + tl;
    const size_t row = rowbase + t;
    const int hg0 = 4 * grp + (j >> 3);
    float gates[3][2];
#pragma unroll
    for (int qt = 0; qt < 2; ++qt)
#pragma unroll
        for (int x = 0; x < 3; ++x) gates[x][qt] = sigmoid_f(__uint_as_float((unsigned)P[row * LDP + 2816 + (hg0 + 2 * qt) * 3 + x] << 16));
    bf16x8 q[2][2];
#pragma unroll
    for (int qt = 0; qt < 2; ++qt)
#pragma unroll
        for (int s = 0; s < 2; ++s) q[qt][s] = scale8(*(const bf16x8*)(P + row * LDP + 1536 + (hg0 + 2 * qt) * 64 + 32 * s + 8 * g), C2);
    __syncthreads();
    f32x4 ofin[2][4];
    LAS float* impl = (LAS float*)(lds + NS_IMP) + w * 8 * 65;
    unsigned selLo = 0u, selHi = 0u, uniLo = 0u, uniHi = 0u;
#ifndef NSA_REP_CMP
#define NSA_REP_CMP 1
#endif
    for (int rep_ = 0; rep_ < NSA_REP_CMP; ++rep_) {
    for (int i = lane; i < 8 * 65; i += 64) impl[i] = 0.f;
    const int nvalid = (t >= 31) ? ((t - 15) >> 4) : 0;
    {
        f32x4 oc[2][4];
#pragma unroll
        for (int qt = 0; qt < 2; ++qt)
#pragma unroll
            for (int dt = 0; dt < 4; ++dt) oc[qt][dt] = (f32x4){0.f, 0.f, 0.f, 0.f};
        float cref[2] = {0.f, 0.f}, lsum[2] = {0.f, 0.f}, prev[2] = {0.f, 0.f};
        float ia[2][8], ib[2][8];
#pragma unroll
        for (int qt = 0; qt < 2; ++qt)
#pragma unroll
            for (int u = 0; u < 8; ++u) { ia[qt][u] = 0.f; ib[qt][u] = 0.f; }
        const f32x4 z4 = (f32x4){0.f, 0.f, 0.f, 0.f};
#pragma unroll
        for (int u = 0; u < 8; ++u) {
            if (u < nu) {
                const bf16x8 ka0 = lds_rd16(lds + NS_KC + (32 * u + j) * P64 + 16 * g), ka1 = lds_rd16(lds + NS_KC + (32 * u + j) * P64 + 64 + 16 * g);
                const bf16x8 kb0 = lds_rd16(lds + NS_KC + (32 * u + 16 + j) * P64 + 16 * g), kb1 = lds_rd16(lds + NS_KC + (32 * u + 16 + j) * P64 + 64 + 16 * g);
                const int tr0 = 32 * u + 4 * g + r4;
                bf16x8 vf[4];
#pragma unroll
                for (int dt = 0; dt < 4; ++dt) vf[dt] = cat4(lds_tr(lds + NS_VC + tr0 * P64 + (16 * dt + 4 * cc) * 2), lds_tr(lds + NS_VC + (tr0 + 16) * P64 + (16 * dt + 4 * cc) * 2));
                f32x4 s0[2], s1[2]; float mloc[2];
#pragma unroll
                for (int qt = 0; qt < 2; ++qt) {
                    s0[qt] = MFMA16(ka0, q[qt][0], z4); s0[qt] = MFMA16(ka1, q[qt][1], s0[qt]); s1[qt] = MFMA16(kb0, q[qt][0], z4); s1[qt] = MFMA16(kb1, q[qt][1], s1[qt]);
                    float ml = NEGB;
#pragma unroll
                    for (int e = 0; e < 4; ++e) { const int c0 = 32 * u + 4 * g + e; s0[qt][e] = (c0 < nvalid) ? s0[qt][e] - cref[qt] : NEGB; s1[qt][e] = (c0 + 16 < nvalid) ? s1[qt][e] - cref[qt] : NEGB;
                        ml = __builtin_fmaxf(__builtin_fmaxf(ml, s0[qt][e]), s1[qt][e]); }
                    mloc[qt] = ml;
                }
                if (__any(fmaxf(mloc[0], mloc[1]) > 8.0f)) {
#pragma unroll
                    for (int qt = 0; qt < 2; ++qt) {
                        const float d = fmaxf(max_g(mloc[qt]), 0.f), alpha = EX2(-d); cref[qt] += d;
                        s0[qt] = s0[qt] - d; s1[qt] = s1[qt] - d; lsum[qt] *= alpha; prev[qt] *= alpha;
#pragma unroll
                        for (int dt = 0; dt < 4; ++dt) oc[qt][dt] = oc[qt][dt] * alpha;
#pragma unroll
                        for (int v = 0; v < 8; ++v) { ia[qt][v] *= alpha; ib[qt][v] *= alpha; }
                    }
                }
#pragma unroll
                for (int qt = 0; qt < 2; ++qt) {
#pragma unroll
                    for (int e = 0; e < 4; ++e) { s0[qt][e] = EX2(s0[qt][e]); s1[qt][e] = EX2(s1[qt][e]); }
                    lsum[qt] += ((s0[qt][0] + s0[qt][1]) + (s0[qt][2] + s0[qt][3])) + ((s1[qt][0] + s1[qt][1]) + (s1[qt][2] + s1[qt][3]));
                    float own0 = (s0[qt][0] + s0[qt][1]) + (s0[qt][2] + 0.5f * s0[qt][3]), own1 = (s1[qt][0] + s1[qt][1]) + (s1[qt][2] + 0.5f * s1[qt][3]);
                    const float car0 = 0.5f * s0[qt][3], car1 = 0.5f * s1[qt][3];
                    const float t0 = __shfl(car0, (lane + 48) & 63), t1 = __shfl(car1, (lane + 48) & 63);
                    own0 += (g == 0) ? prev[qt] : t0; own1 += (g == 0) ? t0 : t1; prev[qt] = t1;
                    ia[qt][u] = own0; ib[qt][u] = own1;
                    const bf16x8 pf = pack8(s0[qt], s1[qt]);
#pragma unroll
                    for (int dt = 0; dt < 4; ++dt) oc[qt][dt] = MFMA16(vf[dt], pf, oc[qt][dt]);
                }
            }
        }
        float inv[2];
#pragma unroll
        for (int qt = 0; qt < 2; ++qt) { const float lt = sum_g(lsum[qt]); inv[qt] = lt > 0.f ? 1.0f / lt : 0.f;
#pragma unroll
            for (int dt = 0; dt < 4; ++dt) ofin[qt][dt] = oc[qt][dt] * (inv[qt] * gates[0][qt]); }
#pragma unroll
        for (int u = 0; u < 8; ++u) {
            if (u < nu) {
                float a0 = ia[0][u] * inv[0] + ia[1][u] * inv[1], a1 = ib[0][u] * inv[0] + ib[1][u] * inv[1];
                a0 += xswz<8>(a0); a1 += xswz<8>(a1);
                if (j < 8) { impl[j * 65 + 8 * u + g] = a0; impl[j * 65 + 8 * u + 4 + g] = a1; }
            }
        }
    }
    if (qi < 16) {
        selLo = uniLo = (1u << (qi + 1)) - 1u; selHi = uniHi = 0u;
    } else {
        LAS unsigned* impu = (LAS unsigned*)impl;
        const int tok = lane >> 3, sub = lane & 7;
        unsigned myk[8]; int rank[8];
#pragma unroll
        for (int k = 0; k < 8; ++k) { const int s = sub + 8 * k; const bool forced = (s == 0) || (s == qi) || (s == qi - 1); const float v = impl[tok * 65 + s] + (forced ? 1e4f : 0.f);
            myk[k] = (s <= qi) ? ((__float_as_uint(v) & 0xFFFFFFC0u) | (unsigned)(63 - s)) : 0u; rank[k] = 0; }
#pragma unroll
        for (int k = 0; k < 8; ++k) impu[tok * 65 + sub + 8 * k] = myk[k];
#pragma unroll 8
        for (int sp = 0; sp < 64; ++sp) { const unsigned v = impu[tok * 65 + sp];
#pragma unroll
            for (int k = 0; k < 8; ++k) rank[k] += (v > myk[k]) ? 1 : 0; }
        unsigned mlo = 0u, mhi = 0u;
#pragma unroll
        for (int k = 0; k < 8; ++k) { const int s = sub + 8 * k; const bool sel = (rank[k] < 16) && (s <= qi); if (sel) { if (k < 4) mlo |= 1u << s; else mhi |= 1u << (s - 32); } }
        mlo |= xswzu<1>(mlo); mhi |= xswzu<1>(mhi); mlo |= xswzu<2>(mlo); mhi |= xswzu<2>(mhi); mlo |= xswzu<4>(mlo); mhi |= xswzu<4>(mhi);
        selLo = __shfl(mlo, (lane & 7) * 8); selHi = __shfl(mhi, (lane & 7) * 8);
        unsigned ulo = mlo, uhi = mhi;
        ulo |= xswzu<8>(ulo); uhi |= xswzu<8>(uhi); ulo |= xswzu<16>(ulo); uhi |= xswzu<16>(uhi); ulo = or_x32(ulo); uhi = or_x32(uhi);
        LAS unsigned* uni = (LAS unsigned*)(lds + NS_UNI);
        if (lane == 0) { uni[2 * w] = ulo; uni[2 * w + 1] = uhi; }
        __syncthreads();
        unsigned a = 0u, bq = 0u;
#pragma unroll
        for (int k = 0; k < 8; ++k) { a |= uni[2 * k]; bq |= uni[2 * k + 1]; }
        uniLo = __builtin_amdgcn_readfirstlane(a); uniHi = __builtin_amdgcn_readfirstlane(bq);
    }
    }
#pragma unroll
    for (int qt = 0; qt < 2; ++qt)
#pragma unroll
        for (int s = 0; s < 2; ++s) q[qt][s] = scale8(*(const bf16x8*)(QR + row * 512 + (hg0 + 2 * qt) * 64 + 32 * s + 8 * g), C2);
    { const float gsel[2] = {gates[1][0], gates[1][1]};
      nsa_branch<0>(lds, P + rowbase * LDP + 2304 + grp * 64, P + rowbase * LDP + 2432 + grp * 64, q, ofin, gsel, qi, tl, ((unsigned long long)selHi << 32) | selLo, ((unsigned long long)uniHi << 32) | uniLo, 0, tid, j, g, r4, cc); }
    { const float gwin[2] = {gates[2][0], gates[2][1]};
      nsa_branch<1>(lds, P + rowbase * LDP + 2560 + grp * 64, P + rowbase * LDP + 2688 + grp * 64, q, ofin, gwin, qi, tl, ~0ull, ~0ull, (qi >= 8 ? qi - 8 : 0), tid, j, g, r4, cc); }
#pragma unroll
    for (int qt = 0; qt < 2; ++qt)
#pragma unroll
        for (int dt = 0; dt < 4; ++dt) { u32x2 o; o.x = cvt_pk_bf16(ofin[qt][dt][0], ofin[qt][dt][1]); o.y = cvt_pk_bf16(ofin[qt][dt][2], ofin[qt][dt][3]);
            __builtin_nontemporal_store(o, (u32x2*)(MIX + row * 1024 + 512 + (hg0 + 2 * qt) * 64 + 16 * dt + 4 * g)); }
    __syncthreads();
}
#define XB_TMO      128
#define XB_XCNT(j)  (256  + 64 * (j))
#define XB_XSUB(j)  (1280 + 64 * (j))
#define XB_XGEN(j)  (2304 + 64 * (j))
#define XB_TOP      3328
#define XB_TOPGEN   3392
#define XCD_BAR_WORDS 3456
#define XB_SPIN_CAP (1u << 18)

__device__ __forceinline__ unsigned xb_ld(unsigned* p)              { return __hip_atomic_load(p, __ATOMIC_RELAXED, __HIP_MEMORY_SCOPE_AGENT); }
__device__ __forceinline__ unsigned xb_add(unsigned* p, unsigned v) { return __hip_atomic_fetch_add(p, v, __ATOMIC_RELAXED, __HIP_MEMORY_SCOPE_AGENT); }
__device__ __forceinline__ unsigned xb_xcc_id() { return (unsigned)__builtin_amdgcn_s_getreg((3 << 11) | 20) & 0xFu; }
#define XB_SPIN(cond, bar) do { unsigned _sp = 0; while (cond) { __builtin_amdgcn_s_sleep(1); \
    if ((++_sp & 255u) == 0u) { if (xb_ld(&(bar)[XB_TMO])) break; if (_sp > XB_SPIN_CAP) { atomicAdd(&(bar)[XB_TMO], 1u); break; } } } } while (0)

struct XcdBarrier {
    unsigned* bar; unsigned x;
    volatile LAS unsigned* st;
};

__device__ __forceinline__ XcdBarrier xcd_barrier_post(unsigned* bar, volatile LAS unsigned* st) {
    XcdBarrier b; b.bar = bar; b.x = xb_xcc_id(); b.st = st;
    if (threadIdx.x == 0) (void)xb_add(&bar[XB_XCNT(b.x)], 1u);
    return b;
}
__device__ __forceinline__ void xcd_barrier_complete(unsigned* bar, unsigned x, unsigned& nloc, unsigned& nx) {
    const unsigned G = gridDim.x * gridDim.y * gridDim.z;
    unsigned sum, cnt, mine, sp = 0u;
    for (;;) {
        sum = 0u; cnt = 0u; mine = 0u;
#pragma unroll
        for (unsigned j = 0; j < 16; ++j) { const unsigned c = xb_ld(&bar[XB_XCNT(j)]); sum += c; cnt += (c > 0u) ? 1u : 0u; mine = (j == x) ? c : mine; }
        if (sum == G) break;
        __builtin_amdgcn_s_sleep(1);
        if ((++sp & 255u) == 0u) { if (xb_ld(&bar[XB_TMO])) break; if (sp > XB_SPIN_CAP) { atomicAdd(&bar[XB_TMO], 1u); break; } }
    }
    nloc = mine > 0u ? mine : 1u; nx = cnt > 0u ? cnt : 1u;
}

__device__ __forceinline__ void xcd_barrier(const XcdBarrier& b) {
    asm volatile("s_waitcnt vmcnt(0)" ::: "memory");
    __syncthreads();
    if (threadIdx.x == 0) {
        unsigned* bar = b.bar;
        __builtin_amdgcn_s_waitcnt(0);
        unsigned nloc = b.st[0], nx = b.st[1];
        if (nloc == 0u) { xcd_barrier_complete(bar, b.x, nloc, nx); b.st[0] = nloc; b.st[1] = nx; }
        const unsigned old = xb_add(&bar[XB_XSUB(b.x)], 1u);
        const unsigned gen = old / nloc;
        if (old + 1u == (gen + 1u) * nloc) {
            __builtin_amdgcn_fence(__ATOMIC_RELEASE, "agent");
            asm volatile("s_waitcnt vmcnt(0)" ::: "memory");
            const unsigned og = xb_add(&bar[XB_TOP], 1u);
            const unsigned tg = og / nx;
            if (og + 1u == (tg + 1u) * nx) xb_add(&bar[XB_TOPGEN], 1u);
            else XB_SPIN(xb_ld(&bar[XB_TOPGEN]) == tg, bar);
            __builtin_amdgcn_fence(__ATOMIC_ACQUIRE, "agent");
            xb_add(&bar[XB_XGEN(b.x)], 1u);
            asm volatile("s_waitcnt vmcnt(0)" ::: "memory");
        } else {
            XB_SPIN(xb_ld(&bar[XB_XGEN(b.x)]) == gen, bar);
            __builtin_amdgcn_fence(__ATOMIC_ACQUIRE, "agent");
            asm volatile("s_waitcnt vmcnt(0)" ::: "memory");
        }
    }
    __syncthreads();
}
#ifndef MK_PER_PHASE
#define MK_PER_PHASE 0
#endif
constexpr int M = 32768, D = 1024, DFF = 2816, NGU = 5632, NIN = 3072, NINV = 2840;
constexpr size_t MiB = 1u << 20;
constexpr size_t WS_SSQ = 0;
constexpr size_t WS_ROPER = 1 * MiB, WS_ROPEN = 2 * MiB, WS_PE = 2 * MiB + 512 * 1024;
constexpr size_t WS_W1K = 3 * MiB, WS_W1V = 4 * MiB, WS_W2K = 5 * MiB, WS_W2V = 5 * MiB + 65536;
constexpr size_t WS_KCMP = 6 * MiB, WS_VCMP = 6 * MiB + 512 * 1024;
constexpr size_t WS_WGU1 = 8 * MiB, WS_WD1 = 20 * MiB, WS_WIN = 26 * MiB, WS_WOUT = 32 * MiB, WS_WGU2 = 34 * MiB, WS_WD2 = 46 * MiB;
constexpr size_t WS_STATE = 52 * MiB, WS_HB = 84 * MiB, WS_XB = 148 * MiB, WS_QROT = 212 * MiB, WS_BIG = 244 * MiB, WS_END = 436 * MiB;
constexpr size_t WS_CTL = 7 * MiB, CTL_BYTES = 65536;
constexpr int LDS_BYTES = 147456, MISC_OFF = 131072;
constexpr int NPHASE = 11;
#ifndef SKIPMASK
#define SKIPMASK 0
#endif
#ifndef WGM_N4
#define WGM_N4 8
#endif
#ifndef REPMASK
#define REPMASK 0
#endif

struct Args { const float* in[22]; float* out; unsigned char* ws; int ph_lo, ph_hi; };

__device__ __forceinline__ float wave_sum(float v) {
#pragma unroll
    for (int o = 1; o < 64; o <<= 1) v += __shfl_xor(v, o);
    return v;
}
__device__ __forceinline__ unsigned f2bf(float f) { unsigned u = __builtin_bit_cast(unsigned, f); return (u + 0x7fffu + ((u >> 16) & 1u)) >> 16; }
__device__ __forceinline__ unsigned pk2(float lo, float hi) { return f2bf(lo) | (f2bf(hi) << 16); }

__device__ __forceinline__ int rowmap(int mode, int n) {
    if (mode == 1) return 256 * (n >> 7) + (n & 127);
    if (mode == 2) return 256 * (n >> 7) + 128 + (n & 127);
    if (mode == 3 && n < 512) { const int hb = n >> 6, d = n & 63, dd = d & 31; return hb * 64 + 8 * (dd >> 2) + (d >= 32 ? 4 : 0) + (dd & 3); }
    return n;
}
__device__ __forceinline__ void p0_transpose_item(const float* W, int K, int ldw, int nvalid, const float* kscale, bf16_t* WT, int mode, LAS float* scr, int nblk, int item, int lane) {
    const int kb = item / nblk, nb = item % nblk, k0 = 64 * kb, n0 = 32 * nb;
    { const int kr = lane >> 3, c4 = (lane & 7) * 4; const bool ok = (n0 + c4) < nvalid;
      f32x4 v[8];
#pragma unroll
      for (int i = 0; i < 8; ++i) v[i] = ok ? *(const f32x4*)(W + (size_t)(k0 + kr + 8 * i) * ldw + n0 + c4) : (f32x4){0.f, 0.f, 0.f, 0.f};
#pragma unroll
      for (int i = 0; i < 8; ++i) { const int kk = kr + 8 * i; const float sc = kscale ? kscale[k0 + kk] : 1.0f;
          scr[kk * 33 + c4 + 0] = v[i][0] * sc; scr[kk * 33 + c4 + 1] = v[i][1] * sc; scr[kk * 33 + c4 + 2] = v[i][2] * sc; scr[kk * 33 + c4 + 3] = v[i][3] * sc; } }
    asm volatile("s_waitcnt lgkmcnt(0)" ::: "memory");
    const int c = lane & 7;
#pragma unroll
    for (int jj = 0; jj < 4; ++jj) { const int nn = (lane >> 3) + 8 * jj; const LAS float* s = scr + (8 * c) * 33 + nn;
        u32x4 o; o.x = pk2(s[0 * 33], s[1 * 33]); o.y = pk2(s[2 * 33], s[3 * 33]); o.z = pk2(s[4 * 33], s[5 * 33]); o.w = pk2(s[6 * 33], s[7 * 33]);
        *(u32x4*)(WT + (size_t)rowmap(mode, n0 + nn) * K + k0 + 8 * c) = o; }
    asm volatile("s_waitcnt lgkmcnt(0)" ::: "memory");
}

__global__ void __launch_bounds__(512, 2) mega_fwd(Args a) {
    extern __shared__ __attribute__((aligned(16))) unsigned char lds_raw[];
    ldsp lds = (ldsp)lds_raw;
    cg::grid_group grid = cg::this_grid();
    const int tid = threadIdx.x, lane = tid & 63, wave = __builtin_amdgcn_readfirstlane(tid >> 6);
    const int G = gridDim.x, bx = blockIdx.x;
    const int lo = a.ph_lo, hi = a.ph_hi;
    unsigned char* ws = a.ws;
    float* ssq0 = (float*)(ws + WS_SSQ); float* ssq1 = ssq0 + M; float* ssq2 = ssq1 + M; float* ssq3 = ssq2 + M;
    float* ropeR = (float*)(ws + WS_ROPER); float* ropeN = (float*)(ws + WS_ROPEN);
    bf16_t* PEb = (bf16_t*)(ws + WS_PE);
    bf16_t* HB = (bf16_t*)(ws + WS_HB); bf16_t* XB = (bf16_t*)(ws + WS_XB); bf16_t* QROT = (bf16_t*)(ws + WS_QROT); bf16_t* BIG = (bf16_t*)(ws + WS_BIG);
    float* ST = (float*)(ws + WS_STATE);
    bf16_t* KCMP = (bf16_t*)(ws + WS_KCMP); bf16_t* VCMP = (bf16_t*)(ws + WS_VCMP);
    float* out = a.out;
    volatile LAS unsigned* MISC = (volatile LAS unsigned*)(lds + MISC_OFF);
    if (tid < 16) MISC[tid] = 0u;
    __syncthreads();
    XcdBarrier bar = xcd_barrier_post((unsigned*)(ws + WS_CTL), MISC + 8);
#define IN(k) (lo <= (k) && (k) < hi)
#define SEAM(k) do { if (IN(k) && IN((k) + 1)) { if (lo < 0) grid.sync(); else xcd_barrier(bar); } } while (0)

    if (IN(0) && !(SKIPMASK & (1 << 0))) {
        for (int rep = 0; rep < (REPMASK & 1) + 1; ++rep) {
        LAS float* scr = (LAS float*)(lds + wave * 16384);
        const int gw = bx * 8 + wave, NGW = G * 8;
        constexpr int I_G = 16 * 88, I_D = 44 * 32, I_IN = 16 * 96, I_O = 16 * 32, I_C1 = 32 * 8, I_C2 = 4 * 2;
        constexpr int NITEMS = 4 * I_G + 2 * I_D + I_IN + I_O + 2 * I_C1 + 2 * I_C2;
        for (int it = gw; it < NITEMS; it += NGW) {
            int r = it;
            if (r < I_G) { p0_transpose_item(a.in[2], 1024, DFF, DFF, a.in[1], (bf16_t*)(ws + WS_WGU1), 1, scr, 88, r, lane); continue; } r -= I_G;
            if (r < I_G) { p0_transpose_item(a.in[3], 1024, DFF, DFF, a.in[1], (bf16_t*)(ws + WS_WGU1), 2, scr, 88, r, lane); continue; } r -= I_G;
            if (r < I_D) { p0_transpose_item(a.in[4], DFF, 1024, 1024, nullptr, (bf16_t*)(ws + WS_WD1), 0, scr, 32, r, lane); continue; } r -= I_D;
            if (r < I_IN) { p0_transpose_item(a.in[6], 1024, NINV, NINV, a.in[5], (bf16_t*)(ws + WS_WIN), 3, scr, 96, r, lane); continue; } r -= I_IN;
            if (r < I_O) { p0_transpose_item(a.in[16], 1024, 1024, 1024, nullptr, (bf16_t*)(ws + WS_WOUT), 0, scr, 32, r, lane); continue; } r -= I_O;
            if (r < I_G) { p0_transpose_item(a.in[18], 1024, DFF, DFF, a.in[17], (bf16_t*)(ws + WS_WGU2), 1, scr, 88, r, lane); continue; } r -= I_G;
            if (r < I_G) { p0_transpose_item(a.in[19], 1024, DFF, DFF, a.in[17], (bf16_t*)(ws + WS_WGU2), 2, scr, 88, r, lane); continue; } r -= I_G;
            if (r < I_D) { p0_transpose_item(a.in[20], DFF, 1024, 1024, nullptr, (bf16_t*)(ws + WS_WD2), 0, scr, 32, r, lane); continue; } r -= I_D;
            if (r < I_C1) { p0_transpose_item(a.in[9], 2048, 256, 256, nullptr, (bf16_t*)(ws + WS_W1K), 0, scr, 8, r, lane); continue; } r -= I_C1;
            if (r < I_C1) { p0_transpose_item(a.in[13], 2048, 256, 256, nullptr, (bf16_t*)(ws + WS_W1V), 0, scr, 8, r, lane); continue; } r -= I_C1;
            if (r < I_C2) { p0_transpose_item(a.in[11], 256, 64, 64, nullptr, (bf16_t*)(ws + WS_W2K), 0, scr, 2, r, lane); continue; } r -= I_C2;
            p0_transpose_item(a.in[15], 256, 64, 64, nullptr, (bf16_t*)(ws + WS_W2V), 0, scr, 2, r, lane);
        }
        const int gt = bx * 512 + tid, NGT = G * 512;
        for (int i = gt; i < 4096; i += NGT) { PEb[i] = (bf16_t)f2bf(a.in[8][i]); PEb[4096 + i] = (bf16_t)f2bf(a.in[12][i]); }
        for (int i = gt; i < 3 * M; i += NGT) ssq1[i] = 0.f;
        const float* x = a.in[0];
        for (int m = gw; m < M; m += 2 * NGW) {
            const int m2 = m + NGW; const bool has2 = m2 < M;
            const f32x4* xr = (const f32x4*)(x + (size_t)m * D) + lane; const f32x4* xr2 = (const f32x4*)(x + (size_t)(has2 ? m2 : m) * D) + lane;
            f32x4 v[4], v2[4]; float s = 0.f, s2 = 0.f;
#pragma unroll
            for (int jj = 0; jj < 4; ++jj) { v[jj] = __builtin_nontemporal_load(xr + 64 * jj); v2[jj] = __builtin_nontemporal_load(xr2 + 64 * jj); }
#pragma unroll
            for (int jj = 0; jj < 4; ++jj) { s += (v[jj][0] * v[jj][0] + v[jj][1] * v[jj][1]) + (v[jj][2] * v[jj][2] + v[jj][3] * v[jj][3]);
                                             s2 += (v2[jj][0] * v2[jj][0] + v2[jj][1] * v2[jj][1]) + (v2[jj][2] * v2[jj][2] + v2[jj][3] * v2[jj][3]); }
            s = wave_sum(s); s2 = wave_sum(s2);
            { const float r1 = __builtin_amdgcn_rsqf(s * (1.0f / 1024.0f) + 1e-6f), r2 = __builtin_amdgcn_rsqf(s2 * (1.0f / 1024.0f) + 1e-6f);
#pragma unroll
              for (int jj = 0; jj < 4; ++jj) { v[jj] = v[jj] * r1; v2[jj] = v2[jj] * r2; } }
            u32x2* o8 = (u32x2*)(XB + (size_t)m * D) + lane; u32x2* o82 = (u32x2*)(XB + (size_t)(has2 ? m2 : m) * D) + lane;
#pragma unroll
            for (int jj = 0; jj < 4; ++jj) { u32x2 o; o.x = cvt_pk_bf16(v[jj][0], v[jj][1]); o.y = cvt_pk_bf16(v[jj][2], v[jj][3]); __builtin_nontemporal_store(o, o8 + 64 * jj);
                if (has2) { u32x2 o2; o2.x = cvt_pk_bf16(v2[jj][0], v2[jj][1]); o2.y = cvt_pk_bf16(v2[jj][2], v2[jj][3]); __builtin_nontemporal_store(o2, o82 + 64 * jj); } }
        }
        }
        __syncthreads();
    }
    SEAM(0);
    if (REPMASK & 1024) { for (int k = 0; k < 10; ++k) grid.sync(); }
    if (IN(1) && !(SKIPMASK & (1 << 1))) { pg8::Gemm g{XB, (const bf16_t*)(ws + WS_WGU1), M, NGU, 1024}; pg8::StaticOrder S; S.init(M, NGU, G, bx);
        pg8::EpiGateUp<false> E{BIG, DFF, nullptr};
        pg8::gemm_phase<pg8::EpiGateUp<false>, pg8::StaticOrder, true, true>(lds, g, S, E);
        if (REPMASK & 2) pg8::gemm_phase<pg8::EpiGateUp<false>, pg8::StaticOrder, true, true>(lds, g, S, E); }
    SEAM(1);
    if (IN(2) && !(SKIPMASK & (1 << 2))) { pg8::Gemm g{BIG, (const bf16_t*)(ws + WS_WD1), M, 1024, DFF}; pg8::StaticOrder S; S.init(M, 1024, G, bx, WGM_N4);
        pg8::EpiResid<true> E{a.in[0], HB, ssq1, 0.5f, (REPMASK & 4) ? 0.5f : 1.0f};
        pg8::gemm_phase<pg8::EpiResid<true>, pg8::StaticOrder, true, true>(lds, g, S, E);
        if (REPMASK & 4) pg8::gemm_phase<pg8::EpiResid<true>, pg8::StaticOrder, true, true>(lds, g, S, E); }
    SEAM(2);
    if (IN(3) && !(SKIPMASK & (1 << 3))) { pg8::Gemm g{HB, (const bf16_t*)(ws + WS_WIN), M, NIN, 1024}; pg8::StaticOrder S; S.init(M, NIN, G, bx);
        pg8::EpiIn E{BIG, QROT, ssq1};
        pg8::gemm_phase<pg8::EpiIn, pg8::StaticOrder, true, true>(lds, g, S, E);
        if (REPMASK & 8) pg8::gemm_phase<pg8::EpiIn, pg8::StaticOrder, true, true>(lds, g, S, E); }
    SEAM(3);
    if (IN(4) && !(SKIPMASK & (1 << 4))) {
        for (int rep = 0; rep < ((REPMASK >> 4) & 1) + 1; ++rep)
        for (int u = bx; u < 1280; u += G) {
            if (u < 256) { const int kv = u >> 7;
                cmp_unit(lds, u & 127, BIG, PEb + kv * 4096, (const bf16_t*)(ws + (kv ? WS_W1V : WS_W1K)), a.in[kv ? 14 : 10], (const bf16_t*)(ws + (kv ? WS_W2V : WS_W2K)), kv ? VCMP : KCMP, kv ? 2176 : 2048); }
            else ret_u_unit(lds, u - 256, BIG, ST);
        }
    }
    SEAM(4);
    if (IN(5) && !(SKIPMASK & (1 << 5))) {
        unsigned* qctr = (unsigned*)(ws + WS_CTL) + 3584;
        unsigned* sctr = (unsigned*)(ws + WS_CTL) + 3648;
        constexpr int NSCAN = 64, U_NSA = NSCAN, U_RET = NSCAN + 1024, U_END = NSCAN + 2048;
        bool scan_ok = false;
        if (tid == 0) MISC[0] = __hip_atomic_fetch_add(qctr, 1u, __ATOMIC_RELAXED, __HIP_MEMORY_SCOPE_AGENT);
        __syncthreads();
        int u = __builtin_amdgcn_readfirstlane((int)MISC[0]);
        while (u < U_END) {
            unsigned nxt = 0u; if (tid == 0) nxt = __hip_atomic_fetch_add(qctr, 1u, __ATOMIC_RELAXED, __HIP_MEMORY_SCOPE_AGENT);
            if (u < U_NSA) {
                const int idx0 = u * 4096 + tid; const int bh = idx0 >> 13; const float gc = exp2f(128.0f * ret_log2g(bh & 3));
                float* p = ST + ((size_t)bh * 32 << 13) + (idx0 & 8191);
                float run[8];
#pragma unroll
                for (int k = 0; k < 8; ++k) run[k] = 0.f;
#pragma unroll 4
                for (int c = 0; c < 32; ++c) {
                    float uu[8];
#pragma unroll
                    for (int k = 0; k < 8; ++k) uu[k] = p[((size_t)c << 13) + 512 * k];
#pragma unroll
                    for (int k = 0; k < 8; ++k) { p[((size_t)c << 13) + 512 * k] = run[k]; run[k] = gc * run[k] + uu[k]; }
                }
                asm volatile("s_waitcnt vmcnt(0)" ::: "memory");
                __syncthreads();
                if (tid == 0) { __builtin_amdgcn_fence(__ATOMIC_RELEASE, "agent"); __hip_atomic_fetch_add(sctr, 1u, __ATOMIC_RELAXED, __HIP_MEMORY_SCOPE_AGENT); }
            } else if (u < U_RET) { const int v = u - U_NSA, qi = 63 - (v >> 4), bg = v & 15; nsa_unit(lds, bg >> 1, bg & 1, qi, BIG, QROT, KCMP, VCMP, XB); }
            else {
                if (!scan_ok) {
                    if (tid == 0) { unsigned sp = 0; while (__hip_atomic_load(sctr, __ATOMIC_RELAXED, __HIP_MEMORY_SCOPE_AGENT) < (unsigned)NSCAN) { __builtin_amdgcn_s_sleep(2); if (++sp > (1u << 22)) break; }
                                    __builtin_amdgcn_fence(__ATOMIC_ACQUIRE, "agent"); }
                    asm volatile("s_waitcnt vmcnt(0)" ::: "memory");
                    __syncthreads();
                    __builtin_amdgcn_fence(__ATOMIC_ACQUIRE, "agent");
                    scan_ok = true;
                }
                ret_out_unit(lds, u - U_RET, BIG, ST, a.in[7], XB);
            }
            if (tid == 0) MISC[0] = nxt;
            __syncthreads();
            u = __builtin_amdgcn_readfirstlane((int)MISC[0]);
        }
    }
    SEAM(5);
    if (IN(7) && !(SKIPMASK & (1 << 7))) { pg8::Gemm g{XB, (const bf16_t*)(ws + WS_WOUT), M, 1024, 1024}; pg8::StaticOrder S; S.init(M, 1024, G, bx, WGM_N4);
        pg8::EpiResid<false> E{nullptr, HB, ssq2, 1.0f, 1.0f};
        pg8::gemm_phase<pg8::EpiResid<false>, pg8::StaticOrder, true, true>(lds, g, S, E); }
    SEAM(7);
    if (IN(8) && !(SKIPMASK & (1 << 8))) { pg8::Gemm g{HB, (const bf16_t*)(ws + WS_WGU2), M, NGU, 1024}; pg8::StaticOrder S; S.init(M, NGU, G, bx);
        pg8::EpiGateUp<true> E{BIG, DFF, ssq2};
        pg8::gemm_phase<pg8::EpiGateUp<true>, pg8::StaticOrder, true, true>(lds, g, S, E); }
    SEAM(8);
    if (IN(9) && !(SKIPMASK & (1 << 9))) { pg8::Gemm g{BIG, (const bf16_t*)(ws + WS_WD2), M, 1024, DFF}; pg8::StaticOrder S; S.init(M, 1024, G, bx, WGM_N4);
        if (G == 256) { pg8::EpiFinal E{HB, out, ssq3, (unsigned*)(ws + WS_CTL) + 4096, a.in[21], 0.5f};
            pg8::gemm_phase<pg8::EpiFinal, pg8::StaticOrder, true, true>(lds, g, S, E); }
        else { pg8::EpiResid<false> E{nullptr, HB, ssq3, 0.5f, 1.0f};
            pg8::gemm_phase<pg8::EpiResid<false>, pg8::StaticOrder, true, true>(lds, g, S, E); } }
    if (G != 256) SEAM(9);
    if (IN(10) && !(SKIPMASK & (1 << 10)) && G != 256) {
        const int gw = bx * 8 + wave, NGW = G * 8; const float* fw = a.in[21];
        f32x4 wv[4];
#pragma unroll
        for (int jj = 0; jj < 4; ++jj) wv[jj] = ((const f32x4*)fw)[lane + 64 * jj];
        for (int m = gw; m < M; m += NGW) {
            const u32x2* hr = (const u32x2*)(HB + (size_t)m * D) + lane; f32x4* xr = (f32x4*)(out + (size_t)m * D) + lane;
            const float r = __builtin_amdgcn_rsqf(ssq3[m] * (1.0f / 1024.0f) + 1e-6f);
#pragma unroll
            for (int jj = 0; jj < 4; ++jj) { const u32x2 hv = hr[64 * jj];
                const f32x4 v = (f32x4){__uint_as_float(hv.x << 16), __uint_as_float(hv.x & 0xffff0000u), __uint_as_float(hv.y << 16), __uint_as_float(hv.y & 0xffff0000u)};
                xr[64 * jj] = v * r * wv[jj]; }
        }
    }
#undef IN
#undef SEAM
}

extern "C" void kernel_launch(void* const* d_in, const int* in_sizes, int n_in, void* d_out, int out_size, void* d_ws, size_t ws_size, hipStream_t stream) {
    static int grid = 0;
    if (grid == 0) {
        if (n_in != 22 || out_size != M * D || ws_size < WS_END) { fprintf(stderr, "kernel_launch: unexpected shapes (n_in %d out %d ws %zu)\n", n_in, out_size, ws_size); grid = -1; return; }
        int dev = 0, cus = 0, per_cu = 0;
        hipGetDevice(&dev); hipDeviceGetAttribute(&cus, hipDeviceAttributeMultiprocessorCount, dev);
        hipFuncSetAttribute((const void*)mega_fwd, hipFuncAttributeMaxDynamicSharedMemorySize, LDS_BYTES);
        hipOccupancyMaxActiveBlocksPerMultiprocessor(&per_cu, (const void*)mega_fwd, 512, LDS_BYTES);
        if (per_cu < 1) { fprintf(stderr, "kernel_launch: occupancy query says %d blocks per CU\n", per_cu); per_cu = 1; }
        (void)hipGetLastError();
        grid = cus * 1;
    }
    if (grid < 0) return;
    if (hipMemsetAsync((char*)d_ws + WS_CTL, 0, CTL_BYTES, stream) != hipSuccess) { fprintf(stderr, "kernel_launch: memset failed\n"); return; }
    Args a{};
    for (int i = 0; i < 22; ++i) a.in[i] = (const float*)d_in[i];
    a.out = (float*)d_out; a.ws = (unsigned char*)d_ws;
#if MK_PER_PHASE
    for (int p = 0; p < NPHASE; ++p) { a.ph_lo = p; a.ph_hi = p + 1; hipLaunchKernelGGL(mega_fwd, dim3(grid), dim3(512), LDS_BYTES, stream, a); }
#else
    a.ph_lo = 0; a.ph_hi = NPHASE;
    void* args[] = {&a};
    hipError_t e = hipLaunchCooperativeKernel((const void*)mega_fwd, dim3(grid), dim3(512), args, LDS_BYTES, stream);
    if (e != hipSuccess) fprintf(stderr, "cooperative launch failed: %s (grid %d)\n", hipGetErrorString(e), grid);
#endif
}
```

```cpp
#include <hip/hip_runtime.h>
#include <hip/hip_cooperative_groups.h>
#include <cstdio>
#include <cstdint>
namespace cg = cooperative_groups;
namespace pg8 {
#define PG8_LAS __attribute__((address_space(3)))
typedef unsigned short bf16_t;
typedef short bf16x8 __attribute__((ext_vector_type(8)));
typedef float f32x4 __attribute__((ext_vector_type(4)));
typedef unsigned u32x4 __attribute__((ext_vector_type(4)));
constexpr int BM = 256, BK = 64, HALF = 128, HTB = HALF * BK * 2  , STAGE_BYTES = 8 * HTB, NXCD = 8;

__host__ __device__ __forceinline__ int lds_byte(int r, int c) { const int st = (r >> 4) * 2 + (c >> 5), rr = r & 15, cc = c & 31, ob = rr * 64 + cc * 2; return st * 1024 + (ob ^ (((ob >> 9) & 1) << 5)); }
__host__ __device__ __forceinline__ void stage_rc(int b, int& R, int& C) { const int st = b / 1024, sb = b % 1024, swz = sb ^ (((sb >> 9) & 1) << 5); R = (st >> 1) * 16 + swz / 64; C = (st & 1) * 32 + (swz % 64) / 2; }
__host__ __device__ __forceinline__ int perm32(int rho) { const int n = rho >> 4, i = rho & 15; return 8 * (i >> 2) + 4 * n + (i & 3); }

struct Unit { int pm, pn; };
struct Gemm { const bf16_t* A; const bf16_t* Bt; int M, N, K; };

struct StaticOrder {
    int nM, nN, nwg, G, c, WGM;
    __host__ __device__ void init(int M, int N, int G_, int c_, int wgm = 4) { nM = M / BM; nN = N / BM; nwg = nM * nN; G = G_; c = c_; WGM = wgm; }
    __host__ __device__ bool next(int i, Unit& u) const {
        const long L = (long)i * G + c; if (L >= nwg) return false;
        int wgid = (int)L; { const int q = nwg / NXCD, r = nwg % NXCD, xcd = wgid % NXCD, off = wgid / NXCD; wgid = (xcd < r ? xcd * (q + 1) : r * (q + 1) + (xcd - r) * q) + off; }
        const int nig = WGM * nN, gid = wgid / nig, fm = gid * WGM, gsz = (nM - fm) < WGM ? (nM - fm) : WGM;
        u.pm = fm + ((wgid % nig) % gsz); u.pn = (wgid % nig) / gsz; return true;
    }
    __device__ __forceinline__ void a_ready(const Unit&) const {}
    __device__ __forceinline__ void done(const Unit&) const {}
};
typedef float f32x2_t __attribute__((ext_vector_type(2))); typedef __bf16 bf16x2_t __attribute__((ext_vector_type(2)));
__device__ __forceinline__ unsigned cvt_pk_bf16(float lo, float hi) { f32x2_t v = {lo, hi}; bf16x2_t b = __builtin_convertvector(v, bf16x2_t); return __builtin_bit_cast(unsigned, b); }
typedef unsigned u32x2 __attribute__((ext_vector_type(2)));
template <int X> __device__ __forceinline__ float xswz(float v) { return __int_as_float(__builtin_amdgcn_ds_swizzle(__float_as_int(v), 0x1f | (X << 10))); }
template <int X> __device__ __forceinline__ unsigned xswzu(unsigned v) { return (unsigned)__builtin_amdgcn_ds_swizzle((int)v, 0x1f | (X << 10)); }
__device__ __forceinline__ float sum_x32(float v) { auto rr = __builtin_amdgcn_permlane32_swap(__float_as_uint(v), __float_as_uint(v), false, false); return __uint_as_float(rr[0]) + __uint_as_float(rr[1]); }
__device__ __forceinline__ float max_x32(float v) { auto rr = __builtin_amdgcn_permlane32_swap(__float_as_uint(v), __float_as_uint(v), false, false); return fmaxf(__uint_as_float(rr[0]), __uint_as_float(rr[1])); }
__device__ __forceinline__ unsigned or_x32(unsigned v) { auto rr = __builtin_amdgcn_permlane32_swap(v, v, false, false); return rr[0] | rr[1]; }
__device__ __forceinline__ float sum_g(float v) { v += xswz<16>(v); return sum_x32(v); }
__device__ __forceinline__ float max_g(float v) { v = fmaxf(v, xswz<16>(v)); return max_x32(v); }

__device__ __forceinline__ float silu_f(float x) { return x * __builtin_amdgcn_rcpf(1.0f + __expf(-x)); }

template <bool SCALE> struct EpiGateUp {
    static constexpr bool PERM = true, AFTER_DRAIN = false; static constexpr int NEP = 8;
    bf16_t* O; int ldo; const float* ssq;
    __device__ __forceinline__ void operator()(const f32x4 (&acc)[2][2][4][2], const Unit& u, int wr, int wc, int fr, int fq) const {
        const int row0 = u.pm * BM + wr * 64 + fr, col0 = u.pn * HALF + wc * 32 + 8 * fq;
        float rs[8];
        if (SCALE) {
#pragma unroll
            for (int k = 0; k < 8; ++k) rs[k] = ssq[row0 + (k >> 2) * HALF + (k & 3) * 16];
#pragma unroll
            for (int k = 0; k < 8; ++k) rs[k] = __builtin_amdgcn_rsqf(rs[k] * (1.0f / 1024.0f) + 1e-6f);
        }
#pragma unroll
        for (int ai = 0; ai < 2; ++ai)
#pragma unroll
            for (int m = 0; m < 4; ++m) {
                const int row = row0 + ai * HALF + m * 16;
                const float r = SCALE ? rs[ai * 4 + m] : 1.0f, k1 = -1.4426950408889634f * r, r2 = r * r;
                typedef float f32x2 __attribute__((ext_vector_type(2)));
                unsigned wv[4];
#pragma unroll
                for (int n = 0; n < 2; ++n)
#pragma unroll
                    for (int p = 0; p < 2; ++p) {
                        const f32x2 g = (f32x2){acc[ai][0][m][n][2 * p], acc[ai][0][m][n][2 * p + 1]}, up = (f32x2){acc[ai][1][m][n][2 * p], acc[ai][1][m][n][2 * p + 1]};
                        const f32x2 t = g * k1; f32x2 ex; ex.x = __builtin_amdgcn_exp2f(t.x); ex.y = __builtin_amdgcn_exp2f(t.y);
                        const f32x2 d = ex + 1.0f; f32x2 rc; rc.x = __builtin_amdgcn_rcpf(d.x); rc.y = __builtin_amdgcn_rcpf(d.y);
                        f32x2 gu = g * up; if (SCALE) gu = gu * r2;
                        const f32x2 h = gu * rc;
                        wv[n * 2 + p] = cvt_pk_bf16(h.x, h.y);
                    }
                u32x4 w; w.x = wv[0]; w.y = wv[1]; w.z = wv[2]; w.w = wv[3];
                __builtin_nontemporal_store(w, (u32x4*)(O + (size_t)row * ldo + col0));
            }
    }
};

template <bool XF> struct EpiResid {
    static constexpr bool PERM = true, AFTER_DRAIN = false; static constexpr int NEP = 16;
    const float* xf; bf16_t* hb; float* ssq; float coef; float ssqw;
    __device__ __forceinline__ void ldbase(f32x4 (&b)[2][2], int row, int col0) const {
#pragma unroll
        for (int bj = 0; bj < 2; ++bj) { const size_t off = (size_t)row * 1024 + col0 + bj * HALF;
            if (XF) { b[bj][0] = *(const f32x4*)(xf + off); b[bj][1] = *(const f32x4*)(xf + off + 4); }
            else { const u32x4 hv = *(const u32x4*)(hb + off); b[bj][0] = __builtin_bit_cast(f32x4, hv); } }
    }
    __device__ __forceinline__ void operator()(const f32x4 (&acc)[2][2][4][2], const Unit& u, int wr, int wc, int fr, int fq) const {
        const int row0 = u.pm * BM + wr * 64 + fr, col0 = u.pn * BM + wc * 32 + 8 * fq;
        f32x4 bb[2][2][2];
        ldbase(bb[0], row0, col0);
#pragma unroll
        for (int k = 0; k < 8; ++k) {
            const int ai = k >> 2, m = k & 3, row = row0 + ai * HALF + m * 16;
            if (k + 1 < 8) ldbase(bb[(k + 1) & 1], row0 + ((k + 1) >> 2) * HALF + ((k + 1) & 3) * 16, col0);
            f32x4 ssv = (f32x4){0.f, 0.f, 0.f, 0.f};
#pragma unroll
            for (int bj = 0; bj < 2; ++bj) {
                const size_t off = (size_t)row * 1024 + col0 + bj * HALF;
                f32x4 b0, b1;
                if (XF) { b0 = bb[k & 1][bj][0]; b1 = bb[k & 1][bj][1]; }
                else { const u32x4 hv = __builtin_bit_cast(u32x4, bb[k & 1][bj][0]);
                    b0 = (f32x4){__uint_as_float(hv.x << 16), __uint_as_float(hv.x & 0xffff0000u), __uint_as_float(hv.y << 16), __uint_as_float(hv.y & 0xffff0000u)};
                    b1 = (f32x4){__uint_as_float(hv.z << 16), __uint_as_float(hv.z & 0xffff0000u), __uint_as_float(hv.w << 16), __uint_as_float(hv.w & 0xffff0000u)}; }
                const f32x4 v0 = b0 + acc[ai][bj][m][0] * coef, v1 = b1 + acc[ai][bj][m][1] * coef;
                ssv = ssv + v0 * v0; ssv = ssv + v1 * v1;
                u32x4 w; w.x = cvt_pk_bf16(v0[0], v0[1]); w.y = cvt_pk_bf16(v0[2], v0[3]); w.z = cvt_pk_bf16(v1[0], v1[1]); w.w = cvt_pk_bf16(v1[2], v1[3]); *(u32x4*)(hb + off) = w;
            }
            float ss = (ssv[0] + ssv[1]) + (ssv[2] + ssv[3]);
            ss = sum_g(ss) * ssqw;
            if (fq == 0) atomicAdd(ssq + row, ss);
        }
    }
};

struct EpiFinal {
    static constexpr bool PERM = true, AFTER_DRAIN = false; static constexpr int NEP = 32;
    const bf16_t* hb; float* out; float* ssq; unsigned* cnt; const float* w; float coef;
    __device__ __forceinline__ void ldbase(u32x4 (&b)[2], int row, int col0) const {
#pragma unroll
        for (int bj = 0; bj < 2; ++bj) b[bj] = *(const u32x4*)(hb + (size_t)row * 1024 + col0 + bj * HALF);
    }
    __device__ __forceinline__ void operator()(f32x4 (&acc)[2][2][4][2], const Unit& u, int wr, int wc, int fr, int fq) const {
        const int row0 = u.pm * BM + wr * 64 + fr, col0 = u.pn * BM + wc * 32 + 8 * fq;
        u32x4 bb[2][2];
        ldbase(bb[0], row0, col0);
#pragma unroll
        for (int k = 0; k < 8; ++k) {
            const int ai = k >> 2, m = k & 3, row = row0 + ai * HALF + m * 16;
            if (k + 1 < 8) ldbase(bb[(k + 1) & 1], row0 + ((k + 1) >> 2) * HALF + ((k + 1) & 3) * 16, col0);
            f32x4 ssv = (f32x4){0.f, 0.f, 0.f, 0.f};
#pragma unroll
            for (int bj = 0; bj < 2; ++bj) {
                const u32x4 hv = bb[k & 1][bj];
                const f32x4 b0 = (f32x4){__uint_as_float(hv.x << 16), __uint_as_float(hv.x & 0xffff0000u), __uint_as_float(hv.y << 16), __uint_as_float(hv.y & 0xffff0000u)};
                const f32x4 b1 = (f32x4){__uint_as_float(hv.z << 16), __uint_as_float(hv.z & 0xffff0000u), __uint_as_float(hv.w << 16), __uint_as_float(hv.w & 0xffff0000u)};
                const f32x4 v0 = b0 + acc[ai][bj][m][0] * coef, v1 = b1 + acc[ai][bj][m][1] * coef;
                acc[ai][bj][m][0] = v0; acc[ai][bj][m][1] = v1;
                ssv = ssv + v0 * v0; ssv = ssv + v1 * v1;
            }
            float ss = (ssv[0] + ssv[1]) + (ssv[2] + ssv[3]);
            ss = sum_g(ss);
            if (fq == 0) atomicAdd(ssq + row, ss);
        }
        asm volatile("s_waitcnt vmcnt(0)" ::: "memory");
        __builtin_amdgcn_s_barrier();
        if (threadIdx.x == 0) {
            __builtin_amdgcn_fence(__ATOMIC_RELEASE, "agent");
            __hip_atomic_fetch_add(cnt + 64 * u.pm, 1u, __ATOMIC_RELAXED, __HIP_MEMORY_SCOPE_AGENT);
            unsigned sp = 0;
            while (__hip_atomic_load(cnt + 64 * u.pm, __ATOMIC_RELAXED, __HIP_MEMORY_SCOPE_AGENT) < 4u) { __builtin_amdgcn_s_sleep(2); if (++sp > (1u << 20)) break; }
            __builtin_amdgcn_fence(__ATOMIC_ACQUIRE, "agent");
        }
        asm volatile("s_waitcnt vmcnt(0) lgkmcnt(0)" ::: "memory");
        __builtin_amdgcn_s_barrier();
        asm volatile("" ::: "memory");
        f32x4 wv[2][2];
#pragma unroll
        for (int bj = 0; bj < 2; ++bj) { wv[bj][0] = *(const f32x4*)(w + col0 + bj * HALF); wv[bj][1] = *(const f32x4*)(w + col0 + bj * HALF + 4); }
        float rs[8];
#pragma unroll
        for (int k = 0; k < 8; ++k) rs[k] = __hip_atomic_load(ssq + row0 + (k >> 2) * HALF + (k & 3) * 16, __ATOMIC_RELAXED, __HIP_MEMORY_SCOPE_AGENT);
#pragma unroll
        for (int k = 0; k < 8; ++k) rs[k] = __builtin_amdgcn_rsqf(rs[k] * (1.0f / 1024.0f) + 1e-6f);
#pragma unroll
        for (int ai = 0; ai < 2; ++ai)
#pragma unroll
            for (int m = 0; m < 4; ++m) {
                const int row = row0 + ai * HALF + m * 16;
                const float r = rs[ai * 4 + m];
#pragma unroll
                for (int bj = 0; bj < 2; ++bj) {
                    const size_t off = (size_t)row * 1024 + col0 + bj * HALF;
                    __builtin_nontemporal_store(acc[ai][bj][m][0] * r * wv[bj][0], (f32x4*)(out + off)); __builtin_nontemporal_store(acc[ai][bj][m][1] * r * wv[bj][1], (f32x4*)(out + off + 4));
                }
            }
    }
};

struct EpiIn {
    static constexpr bool PERM = true, AFTER_DRAIN = false; static constexpr int NEP = 16;
    bf16_t* P; bf16_t* QR; const float* ssq;
    __device__ __forceinline__ void operator()(const f32x4 (&acc)[2][2][4][2], const Unit& u, int wr, int wc, int fr, int fq) const {
        const int row0 = u.pm * BM + wr * 64 + fr, cw = wc * 32 + 8 * fq, col0 = u.pn * BM + cw;
        const int pn = u.pn;
        const int q8 = ((cw & 63) >> 3);
        const bool isret = pn <= 1, isnsa = (pn == 6 || pn == 7 || pn == 9 || pn == 10);
        f32x4 fr0 = (f32x4){0.f, 0.f, 0.f, 0.f}, fr1 = fr0;
        if (isret) {
#pragma unroll
            for (int j = 0; j < 4; ++j) fr0[j] = __builtin_amdgcn_exp2f(-(float)(4 * q8 + j) * (2.0f / 64.0f) * 13.287712379549449f) * 0.15915494309189535f;
        } else if (isnsa) {
#pragma unroll
            for (int j = 0; j < 4; ++j) { fr0[j] = __builtin_amdgcn_exp2f(-(float)j * (2.0f / 16.0f) * 18.931568569324174f) * 0.15915494309189535f;
                                          fr1[j] = __builtin_amdgcn_exp2f(-(float)(4 + j) * (2.0f / 16.0f) * 18.931568569324174f) * 0.15915494309189535f; }
        }
        float rs[8];
#pragma unroll
        for (int k = 0; k < 8; ++k) rs[k] = ssq[row0 + (k >> 2) * HALF + (k & 3) * 16];
#pragma unroll
        for (int k = 0; k < 8; ++k) rs[k] = __builtin_amdgcn_rsqf(rs[k] * (1.0f / 1024.0f) + 1e-6f);
#pragma unroll
        for (int ai = 0; ai < 2; ++ai)
#pragma unroll
            for (int m = 0; m < 4; ++m) {
                const int row = row0 + ai * HALF + m * 16; const float pos = (float)(row & 4095);
                const float r = rs[ai * 4 + m];
                f32x4 c0 = (f32x4){1.f, 1.f, 1.f, 1.f}, s0 = (f32x4){0.f, 0.f, 0.f, 0.f}, c1 = c0, s1 = s0;
                if (isret || isnsa) {
#pragma unroll
                    for (int j = 0; j < 4; ++j) { const float a0 = __builtin_amdgcn_fractf(pos * fr0[j]); c0[j] = __builtin_amdgcn_cosf(a0); s0[j] = __builtin_amdgcn_sinf(a0); }
                    if (isnsa) {
#pragma unroll
                        for (int j = 0; j < 4; ++j) { const float a1 = __builtin_amdgcn_fractf(pos * fr1[j]); c1[j] = __builtin_amdgcn_cosf(a1); s1[j] = __builtin_amdgcn_sinf(a1); }
                    }
                }
#pragma unroll
                for (int bj = 0; bj < 2; ++bj) {
                    f32x4 v0 = acc[ai][bj][m][0] * r, v1 = acc[ai][bj][m][1] * r;
                    bf16_t* dst = P + (size_t)row * 3072 + col0 + bj * HALF;
                    if (isret) {
                        f32x4 o0 = v0 * c0 - v1 * s0, o1 = v1 * c0 + v0 * s0;
                        if (pn == 1) { o0 = o0 * 0.125f; o1 = o1 * 0.125f; }
                        v0 = o0; v1 = o1;
                    } else if (pn == 6 || pn == 7 || ((pn == 9 || pn == 10) && bj == 0)) {
                        if (pn <= 7) { u32x4 w; w.x = cvt_pk_bf16(v0[0], v0[1]); w.y = cvt_pk_bf16(v0[2], v0[3]); w.z = cvt_pk_bf16(v1[0], v1[1]); w.w = cvt_pk_bf16(v1[2], v1[3]); *(u32x4*)dst = w;
                                       dst = QR + (size_t)row * 512 + (pn - 6) * BM + bj * HALF + cw; }
                        f32x4 p0, p1;
#pragma unroll
                        for (int j = 0; j < 4; ++j) { p0[j] = xswz<16>(v0[j]); p1[j] = xswz<16>(v1[j]); }
                        if (q8 == 0) { v0 = v0 * c0 - p0 * s0; v1 = v1 * c1 - p1 * s1; }
                        else if (q8 == 1) { v0 = v0 * c0 + p0 * s0; v1 = v1 * c1 + p1 * s1; }
                    }
                    u32x4 w; w.x = cvt_pk_bf16(v0[0], v0[1]); w.y = cvt_pk_bf16(v0[2], v0[3]); w.z = cvt_pk_bf16(v1[0], v1[1]); w.w = cvt_pk_bf16(v1[2], v1[3]);
                    __builtin_nontemporal_store(w, (u32x4*)dst);
                }
            }
    }
};
template <class Epi, class Sched, bool ALIGN_EPI = false, bool SP2 = false>
__device__ __forceinline__ void gemm_phase(PG8_LAS unsigned char* lds, const Gemm g, const Sched& S, const Epi& E) {
    const int tid = threadIdx.x, wid = __builtin_amdgcn_readfirstlane(tid >> 6), lane = tid & 63, wr = wid >> 2, wc = wid & 3, fr = lane & 15, fq = lane >> 4;
    const int K = g.K, nt = K / BK;
    unsigned voffA[2], voffB[2];
#pragma unroll
    for (int i = 0; i < 2; ++i) { int R, C; stage_rc(tid * 16 + i * 8192, R, C); const int Rb = Epi::PERM ? ((R & ~31) + perm32(R & 31)) : R;
        voffA[i] = (unsigned)(R * K + C) * 2u; voffB[i] = (unsigned)(Rb * K + C) * 2u; }
    const size_t kstep = (size_t)(BK * 2);
    const size_t hstep = (size_t)HALF * K * 2;
    const size_t tstep = 2 * hstep;
    const unsigned ldsw = (unsigned)wid * 1024u;
    const int aoff = lds_byte(wr * 64 + fr, fq * 8), boff = lds_byte(wc * 32 + fr, fq * 8);
#define PG8_SA(b, h) (((b) * 2 + (h)) * HTB)
#define PG8_SB(b, h) ((4 + (b) * 2 + (h)) * HTB)
#define PG8_STAGE(bufoff, gbase, voff) do { _Pragma("unroll") for (int _i = 0; _i < 2; ++_i) \
        __builtin_amdgcn_global_load_lds((const unsigned*)((const char*)(gbase) + (voff)[_i]), (PG8_LAS unsigned*)(lds + (bufoff) + ldsw + _i * 8192), 16, 0, 0); } while (0)
#define PG8_LDA(dst, b, h) do { _Pragma("unroll") for (int m = 0; m < 4; ++m) _Pragma("unroll") for (int k = 0; k < 2; ++k) dst[m][k] = *(const PG8_LAS bf16x8*)(lds + PG8_SA(b, h) + aoff + m * 2048 + k * 1024); } while (0)
#define PG8_LDB(dst, b, h) do { _Pragma("unroll") for (int n = 0; n < 2; ++n) _Pragma("unroll") for (int k = 0; k < 2; ++k) dst[n][k] = *(const PG8_LAS bf16x8*)(lds + PG8_SB(b, h) + boff + n * 2048 + k * 1024); } while (0)
#define PG8_MMA(ai, bj, At, Bt) do { __builtin_amdgcn_s_setprio(1); _Pragma("unroll") for (int m = 0; m < 4; ++m) _Pragma("unroll") for (int n = 0; n < 2; ++n) _Pragma("unroll") for (int k = 0; k < 2; ++k) \
        acc[ai][bj][m][n] = __builtin_amdgcn_mfma_f32_16x16x32_bf16(Bt[n][k], At[m][k], acc[ai][bj][m][n], 0, 0, 0); __builtin_amdgcn_s_setprio(0); } while (0)
#define PG8_WAIT_V(n) asm volatile("s_waitcnt vmcnt(" #n ")" ::: "memory")
#define PG8_WAIT_V8B asm volatile("s_waitcnt vmcnt(%1)\n\ts_cmp_eq_u32 %0, 0\n\ts_cbranch_scc1 1f\n\ts_waitcnt vmcnt(8)\n1:" :: "s"(strict), "n"(8 + Epi::NEP) : "memory", "scc")
#define PG8_WAIT_L(n) asm volatile("s_waitcnt lgkmcnt(" #n ")" ::: "memory")
#define PG8_BAR __builtin_amdgcn_s_barrier()
#define PG8_SCHED __builtin_amdgcn_sched_barrier(0)
    Unit cur, nxt; int ui = 0;
    if (!S.next(0, cur)) return;
    f32x4 acc[2][2][4][2];
#pragma unroll
    for (int a = 0; a < 2; ++a)
#pragma unroll
        for (int b = 0; b < 2; ++b)
#pragma unroll
            for (int m = 0; m < 4; ++m)
#pragma unroll
                for (int n = 0; n < 2; ++n) acc[a][b][m][n] = (f32x4){0.f, 0.f, 0.f, 0.f};
    bf16x8 At[4][2], B0[2][2], B1[2][2];
    const char* cA = (const char*)g.A + (size_t)cur.pm * tstep; const char* cB = (const char*)g.Bt + (size_t)cur.pn * tstep;
    S.a_ready(cur);
    if constexpr (SP2) {
        PG8_STAGE(PG8_SB(0, 0), cB, voffB); PG8_STAGE(PG8_SB(0, 1), cB + hstep, voffB); PG8_STAGE(PG8_SA(0, 0), cA, voffA); PG8_STAGE(PG8_SA(0, 1), cA + hstep, voffA);
        if (wr == 1) PG8_BAR;
        PG8_WAIT_V(2); PG8_BAR;
        PG8_STAGE(PG8_SB(1, 0), cB + kstep, voffB); PG8_STAGE(PG8_SA(1, 0), cA + kstep, voffA); PG8_STAGE(PG8_SB(1, 1), cB + hstep + kstep, voffB);
        PG8_WAIT_V(6); PG8_BAR;
    } else {
        PG8_STAGE(PG8_SB(0, 0), cB, voffB); PG8_STAGE(PG8_SA(0, 0), cA, voffA); PG8_STAGE(PG8_SB(0, 1), cB + hstep, voffB); PG8_STAGE(PG8_SA(0, 1), cA + hstep, voffA);
        if (wr == 1) PG8_BAR;
        PG8_WAIT_V(4); PG8_BAR;
        PG8_STAGE(PG8_SB(1, 0), cB + kstep, voffB); PG8_STAGE(PG8_SA(1, 0), cA + kstep, voffA); PG8_STAGE(PG8_SB(1, 1), cB + hstep + kstep, voffB);
        PG8_WAIT_V(6); PG8_BAR;
    }
    for (;;) {
        const bool has_next = S.next(ui + 1, nxt);
        const char* nA = has_next ? (const char*)g.A + (size_t)nxt.pm * tstep : cA; const char* nB = has_next ? (const char*)g.Bt + (size_t)nxt.pn * tstep : cB;
        for (int t = 0; t < nt; t += 2) {
            const bool last = (t == nt - 2);
            const char* a1 = cA + (size_t)(t + 1) * kstep;
            const char* a2 = last ? nA : cA + (size_t)(t + 2) * kstep; const char* b2 = last ? nB : cB + (size_t)(t + 2) * kstep;
            const char* a3 = a2 + kstep; const char* b3 = b2 + kstep;
            if (last && has_next) S.a_ready(nxt);
            const int strict = __builtin_amdgcn_readfirstlane((t == 0 && ui > 0) ? 0 : 1);
            if constexpr (SP2) {
            PG8_LDB(B0, 0, 0); PG8_LDB(B1, 0, 1); PG8_SCHED; PG8_LDA(At, 0, 0); PG8_STAGE(PG8_SA(1, 1), a1 + hstep, voffA);
            PG8_WAIT_V8B; PG8_WAIT_L(0); PG8_BAR; PG8_MMA(0, 0, At, B0); PG8_MMA(0, 1, At, B1); PG8_BAR; PG8_SCHED;
            PG8_LDA(At, 0, 1); PG8_STAGE(PG8_SB(0, 0), b2, voffB); PG8_STAGE(PG8_SB(0, 1), b2 + hstep, voffB); PG8_STAGE(PG8_SA(0, 0), a2, voffA);
            PG8_WAIT_V8B; PG8_WAIT_L(0); PG8_BAR; PG8_MMA(1, 0, At, B0); PG8_MMA(1, 1, At, B1); PG8_BAR; PG8_SCHED;
            PG8_LDB(B0, 1, 0); PG8_LDB(B1, 1, 1); PG8_SCHED; PG8_LDA(At, 1, 0); PG8_STAGE(PG8_SA(0, 1), a2 + hstep, voffA);
            PG8_WAIT_V(8); PG8_WAIT_L(0); PG8_BAR; PG8_MMA(0, 0, At, B0); PG8_MMA(0, 1, At, B1); PG8_BAR; PG8_SCHED;
            PG8_LDA(At, 1, 1); PG8_STAGE(PG8_SB(1, 0), b3, voffB); PG8_STAGE(PG8_SB(1, 1), b3 + hstep, voffB); PG8_STAGE(PG8_SA(1, 0), a3, voffA);
            PG8_WAIT_V(8); PG8_WAIT_L(0); PG8_BAR; PG8_MMA(1, 0, At, B0); PG8_MMA(1, 1, At, B1); PG8_BAR; PG8_SCHED;
            } else {
            PG8_LDB(B0, 0, 0); PG8_SCHED; PG8_LDA(At, 0, 0); PG8_STAGE(PG8_SA(1, 1), a1 + hstep, voffA);
            PG8_WAIT_L(8); PG8_BAR; PG8_WAIT_L(0); PG8_MMA(0, 0, At, B0); PG8_BAR; PG8_SCHED;
            PG8_LDB(B1, 0, 1); PG8_STAGE(PG8_SB(0, 0), b2, voffB);
            PG8_BAR; PG8_WAIT_L(0); PG8_MMA(0, 1, At, B1); PG8_BAR;
            PG8_LDA(At, 0, 1); PG8_STAGE(PG8_SA(0, 0), a2, voffA);
            PG8_BAR; PG8_WAIT_L(0); PG8_MMA(1, 0, At, B0); PG8_BAR; PG8_SCHED;
            PG8_STAGE(PG8_SB(0, 1), b2 + hstep, voffB);
            PG8_WAIT_V(6); PG8_BAR; PG8_MMA(1, 1, At, B1); PG8_BAR;
            PG8_LDB(B0, 1, 0); PG8_SCHED; PG8_LDA(At, 1, 0); PG8_STAGE(PG8_SA(0, 1), a2 + hstep, voffA);
            PG8_WAIT_L(8); PG8_BAR; PG8_WAIT_L(0); PG8_MMA(0, 0, At, B0); PG8_BAR; PG8_SCHED;
            PG8_LDB(B1, 1, 1); PG8_STAGE(PG8_SB(1, 0), b3, voffB);
            PG8_BAR; PG8_WAIT_L(0); PG8_MMA(0, 1, At, B1); PG8_BAR;
            PG8_LDA(At, 1, 1); PG8_STAGE(PG8_SA(1, 0), a3, voffA);
            PG8_BAR; PG8_WAIT_L(0); PG8_MMA(1, 0, At, B0); PG8_BAR; PG8_SCHED;
            PG8_STAGE(PG8_SB(1, 1), b3 + hstep, voffB);
            PG8_WAIT_V(6); PG8_BAR; PG8_MMA(1, 1, At, B1); PG8_BAR;
            }
        }
        if constexpr (ALIGN_EPI) { if (wr == 0) PG8_BAR; }
        if constexpr (!Epi::AFTER_DRAIN) { E(acc, cur, wr, wc, fr, fq); S.done(cur); }
        if (!has_next) break;
#pragma unroll
        for (int a = 0; a < 2; ++a)
#pragma unroll
            for (int b = 0; b < 2; ++b)
#pragma unroll
                for (int m = 0; m < 4; ++m)
#pragma unroll
                    for (int n = 0; n < 2; ++n) acc[a][b][m][n] = (f32x4){0.f, 0.f, 0.f, 0.f};
        cur = nxt; cA = nA; cB = nB; ++ui;
        if constexpr (ALIGN_EPI) { if (wr == 1) PG8_BAR; }
    }
    PG8_WAIT_V(0);
    if constexpr (!ALIGN_EPI) { if (wr == 0) PG8_BAR; }
    PG8_BAR;
    if constexpr (Epi::AFTER_DRAIN) { E.fused(acc, cur, wr, wc, fr, fq, lds, wid, lane); S.done(cur); }
#undef PG8_SA
#undef PG8_SB
#undef PG8_STAGE
#undef PG8_LDA
#undef PG8_LDB
#undef PG8_MMA
#undef PG8_WAIT_V
#undef PG8_WAIT_V8B
#undef PG8_WAIT_L
#undef PG8_BAR
#undef PG8_SCHED
}
}
using pg8::bf16_t; using pg8::bf16x8; using pg8::f32x4; using pg8::u32x4; using pg8::u32x2; using pg8::cvt_pk_bf16; using pg8::xswz; using pg8::xswzu; using pg8::sum_x32; using pg8::max_x32; using pg8::or_x32; using pg8::sum_g; using pg8::max_g;
#define LAS __attribute__((address_space(3)))
typedef LAS unsigned char* ldsp;
typedef short s16x4 __attribute__((ext_vector_type(4)));
typedef short v4i16_t __attribute__((ext_vector_type(4)));
__device__ __forceinline__ bf16x8 lds_rd16(ldsp p) { return *(const LAS bf16x8*)p; }
__device__ __forceinline__ s16x4 lds_tr(ldsp p) { return __builtin_bit_cast(s16x4, __builtin_amdgcn_ds_read_tr16_b64_v4i16((LAS v4i16_t*)p)); }
__device__ __forceinline__ bf16x8 cat4(s16x4 a, s16x4 b) { return (bf16x8){a[0], a[1], a[2], a[3], b[0], b[1], b[2], b[3]}; }
__device__ __forceinline__ bf16x8 pack8(const f32x4& a, const f32x4& b) {
    u32x4 w; w.x = cvt_pk_bf16(a[0], a[1]); w.y = cvt_pk_bf16(a[2], a[3]); w.z = cvt_pk_bf16(b[0], b[1]); w.w = cvt_pk_bf16(b[2], b[3]); return __builtin_bit_cast(bf16x8, w); }
__device__ __forceinline__ float bflo(unsigned w) { return __uint_as_float(w << 16); }
__device__ __forceinline__ float bfhi(unsigned w) { return __uint_as_float(w & 0xffff0000u); }
#define MFMA16(a, b, c) __builtin_amdgcn_mfma_f32_16x16x32_bf16((a), (b), (c), 0, 0, 0)
constexpr int P64 = 144, P128 = 272;
constexpr int LDP = 3072;
constexpr float C2 = 0.125f * 1.4426950408889634f;
constexpr float NEGB = -1e30f;

__device__ __forceinline__ float ret_log2g(int h) { return __log2f(1.0f - exp2f(-5.0f - (float)h)); }

template <int NIT> __device__ __forceinline__ void stage64(ldsp dst, const bf16_t* src, size_t ld, int rows, int tid) {
    u32x4 v[NIT];
#pragma unroll
    for (int i = 0; i < NIT; ++i) { const int idx = tid + 512 * i, r = idx >> 3, ch = idx & 7; if (idx < rows * 8) v[i] = *(const u32x4*)(src + (size_t)r * ld + ch * 8); }
#pragma unroll
    for (int i = 0; i < NIT; ++i) { const int idx = tid + 512 * i, r = idx >> 3, ch = idx & 7; if (idx < rows * 8) *(LAS u32x4*)(dst + r * P64 + ch * 16) = v[i]; }
}
template <int NIT> __device__ __forceinline__ void stage128(ldsp dst, const bf16_t* src, size_t ld, int rows, int tid) {
    u32x4 v[NIT];
#pragma unroll
    for (int i = 0; i < NIT; ++i) { const int idx = tid + 512 * i, r = idx >> 4, ch = idx & 15; if (idx < rows * 16) v[i] = *(const u32x4*)(src + (size_t)r * ld + ch * 8); }
#pragma unroll
    for (int i = 0; i < NIT; ++i) { const int idx = tid + 512 * i, r = idx >> 4, ch = idx & 15; if (idx < rows * 16) *(LAS u32x4*)(dst + r * P128 + ch * 16) = v[i]; }
}

__device__ __forceinline__ void ret_u_unit(ldsp lds, int unit, const bf16_t* P, float* ST) {
    int tid = threadIdx.x; asm volatile("" : "+v"(tid)); const int lane = tid & 63, w = __builtin_amdgcn_readfirstlane(tid >> 6), j = lane & 15, g = lane >> 4, r4 = j >> 2, cc = lane & 3;
    const int c = unit & 31, h = (unit >> 5) & 3, b = unit >> 7;
    const size_t row0 = (size_t)b * 4096 + c * 128;
    const float l2g = ret_log2g(h);
    const ldsp RK = lds, RV = lds + 18432;
    u32x4 kv[2];
#pragma unroll
    for (int i = 0; i < 2; ++i) { const int idx = tid + 512 * i, r = idx >> 3, ch = idx & 7; kv[i] = *(const u32x4*)(P + (row0 + r) * LDP + 256 + h * 64 + ch * 8); }
    stage128<4>(RV, P + row0 * LDP + 512 + h * 128, LDP, 128, tid);
#pragma unroll
    for (int i = 0; i < 2; ++i) { const int idx = tid + 512 * i, r = idx >> 3, ch = idx & 7; const u32x4 v = kv[i];
        const float z = exp2f((float)(127 - r) * l2g); u32x4 o;
        o.x = cvt_pk_bf16(bflo(v.x) * z, bfhi(v.x) * z); o.y = cvt_pk_bf16(bflo(v.y) * z, bfhi(v.y) * z); o.z = cvt_pk_bf16(bflo(v.z) * z, bfhi(v.z) * z); o.w = cvt_pk_bf16(bflo(v.w) * z, bfhi(v.w) * z);
        *(LAS u32x4*)(RK + r * P64 + ch * 16) = o; }
    __syncthreads();
    f32x4 acc[4];
#pragma unroll
    for (int dt = 0; dt < 4; ++dt) acc[dt] = (f32x4){0.f, 0.f, 0.f, 0.f};
#pragma unroll
    for (int ks = 0; ks < 4; ++ks) {
        const int tr0 = 32 * ks + 8 * g + r4;
        const bf16x8 vf = cat4(lds_tr(RV + tr0 * P128 + (16 * w + 4 * cc) * 2), lds_tr(RV + (tr0 + 4) * P128 + (16 * w + 4 * cc) * 2));
#pragma unroll
        for (int dt = 0; dt < 4; ++dt) {
            const bf16x8 kf = cat4(lds_tr(RK + tr0 * P64 + (16 * dt + 4 * cc) * 2), lds_tr(RK + (tr0 + 4) * P64 + (16 * dt + 4 * cc) * 2));
            acc[dt] = MFMA16(kf, vf, acc[dt]);
        }
    }
    float* U = ST + (size_t)unit * 8192;
#pragma unroll
    for (int dt = 0; dt < 4; ++dt)
#pragma unroll
        for (int e = 0; e < 4; ++e) U[(16 * dt + 4 * g + e) * 128 + 16 * w + j] = acc[dt][e];
    __syncthreads();
}

__device__ __forceinline__ void ret_out_unit(ldsp lds, int unit, const bf16_t* P, const float* ST, const float* gnw, bf16_t* MIX) {
    int tid = threadIdx.x; asm volatile("" : "+v"(tid)); const int lane = tid & 63, w = __builtin_amdgcn_readfirstlane(tid >> 6), j = lane & 15, g = lane >> 4, r4 = j >> 2, cc = lane & 3;
    const int c = unit & 31, h = (unit >> 5) & 3, b = unit >> 7;
    const size_t row0 = (size_t)b * 4096 + c * 128;
    const float l2g = ret_log2g(h);
    const ldsp OQ = lds, OK = lds + 18432, OV = lds + 36864, OS = lds + 71680;
    {
      u32x4 vq[2], vk[2], vv[4]; f32x4 vs[4];
      const float* S = ST + (size_t)unit * 8192;
#pragma unroll
      for (int i = 0; i < 2; ++i) { const int idx = tid + 512 * i, r = idx >> 3, ch = idx & 7; vq[i] = *(const u32x4*)(P + (row0 + r) * LDP + h * 64 + ch * 8); vk[i] = *(const u32x4*)(P + (row0 + r) * LDP + 256 + h * 64 + ch * 8); }
#pragma unroll
      for (int i = 0; i < 4; ++i) { const int idx = tid + 512 * i, r = idx >> 4, ch = idx & 15; vv[i] = *(const u32x4*)(P + (row0 + r) * LDP + 512 + h * 128 + ch * 8); }
#pragma unroll
      for (int k = 0; k < 4; ++k) { const int idx = tid + 512 * k, d = idx >> 5, e4 = idx & 31; vs[k] = *(const f32x4*)(S + d * 128 + 4 * e4); }
#pragma unroll
      for (int i = 0; i < 2; ++i) { const int idx = tid + 512 * i, r = idx >> 3, ch = idx & 7; *(LAS u32x4*)(OQ + r * P64 + ch * 16) = vq[i]; *(LAS u32x4*)(OK + r * P64 + ch * 16) = vk[i]; }
#pragma unroll
      for (int i = 0; i < 4; ++i) { const int idx = tid + 512 * i, r = idx >> 4, ch = idx & 15; *(LAS u32x4*)(OV + r * P128 + ch * 16) = vv[i]; }
#pragma unroll
      for (int k = 0; k < 4; ++k) { const int idx = tid + 512 * k, d = idx >> 5, e4 = idx & 31; u32x2 o; o.x = cvt_pk_bf16(vs[k][0], vs[k][1]); o.y = cvt_pk_bf16(vs[k][2], vs[k][3]); *(LAS u32x2*)(OS + d * P128 + e4 * 8) = o; }
    }
    __syncthreads();
    bf16x8 qf[2];
#pragma unroll
    for (int s = 0; s < 2; ++s) qf[s] = lds_rd16(OQ + (16 * w + j) * P64 + 64 * s + 16 * g);
    f32x4 tot[8];
#pragma unroll
    for (int et = 0; et < 8; ++et) tot[et] = (f32x4){0.f, 0.f, 0.f, 0.f};
#pragma unroll
    for (int ks = 0; ks < 2; ++ks) {
        const int tr0 = 32 * ks + 8 * g + r4;
#pragma unroll
        for (int et = 0; et < 8; ++et) {
            const bf16x8 sf = cat4(lds_tr(OS + tr0 * P128 + (16 * et + 4 * cc) * 2), lds_tr(OS + (tr0 + 4) * P128 + (16 * et + 4 * cc) * 2));
            tot[et] = MFMA16(sf, qf[ks], tot[et]);
        }
    }
    const int n = 16 * w + j;
    { const float xi = exp2f((float)(n + 1) * l2g);
#pragma unroll
      for (int et = 0; et < 8; ++et) tot[et] = tot[et] * xi; }
#pragma unroll
    for (int u = 0; u < 4; ++u) {
        if (2 * u <= w) {
            f32x4 s0 = (f32x4){0.f, 0.f, 0.f, 0.f}, s1 = (f32x4){0.f, 0.f, 0.f, 0.f};
#pragma unroll
            for (int s = 0; s < 2; ++s) {
                s0 = MFMA16(lds_rd16(OK + (32 * u + j) * P64 + 64 * s + 16 * g), qf[s], s0);
                s1 = MFMA16(lds_rd16(OK + (32 * u + 16 + j) * P64 + 64 * s + 16 * g), qf[s], s1);
            }
#pragma unroll
            for (int e = 0; e < 4; ++e) { const int d0 = n - (32 * u + 4 * g + e), d1 = d0 - 16;
                s0[e] = d0 >= 0 ? s0[e] * exp2f((float)d0 * l2g) : 0.f; s1[e] = d1 >= 0 ? s1[e] * exp2f((float)d1 * l2g) : 0.f; }
            const bf16x8 pf = pack8(s0, s1);
            const int tr0 = 32 * u + 4 * g + r4;
#pragma unroll
            for (int et = 0; et < 8; ++et) {
                const bf16x8 vf = cat4(lds_tr(OV + tr0 * P128 + (16 * et + 4 * cc) * 2), lds_tr(OV + (tr0 + 16) * P128 + (16 * et + 4 * cc) * 2));
                tot[et] = MFMA16(vf, pf, tot[et]);
            }
        }
    }
    float s1 = 0.f;
#pragma unroll
    for (int et = 0; et < 8; ++et) s1 += (tot[et][0] + tot[et][1]) + (tot[et][2] + tot[et][3]);
    s1 = sum_g(s1);
    const float mu = s1 * (1.0f / 128.0f); float s2 = 0.f;
#pragma unroll
    for (int et = 0; et < 8; ++et) { tot[et] = tot[et] - mu; s2 += (tot[et][0] * tot[et][0] + tot[et][1] * tot[et][1]) + (tot[et][2] * tot[et][2] + tot[et][3] * tot[et][3]); }
    s2 = sum_g(s2);
    const float rs = __builtin_amdgcn_rsqf(s2 * (1.0f / 128.0f) + 1e-5f);
    const size_t row = row0 + n;
    f32x4 gwv[8]; u32x2 rgw[8];
#pragma unroll
    for (int et = 0; et < 8; ++et) { const int e0 = h * 128 + 16 * et + 4 * g; gwv[et] = *(const f32x4*)(gnw + e0); rgw[et] = *(const u32x2*)(P + row * LDP + 1024 + e0); }
#pragma unroll
    for (int et = 0; et < 8; ++et) {
        const int e0 = h * 128 + 16 * et + 4 * g;
        const f32x4 gw = gwv[et]; const u32x2 rgv = rgw[et];
        const float r0 = bflo(rgv.x), r1 = bfhi(rgv.x), r2 = bflo(rgv.y), r3 = bfhi(rgv.y);
        const float o0 = tot[et][0] * rs * gw[0] * pg8::silu_f(r0), o1 = tot[et][1] * rs * gw[1] * pg8::silu_f(r1);
        const float o2 = tot[et][2] * rs * gw[2] * pg8::silu_f(r2), o3 = tot[et][3] * rs * gw[3] * pg8::silu_f(r3);
        u32x2 o; o.x = cvt_pk_bf16(o0, o1); o.y = cvt_pk_bf16(o2, o3);
        *(u32x2*)(MIX + row * 1024 + e0) = o;
    }
    __syncthreads();
}

__device__ __forceinline__ float gelu_tanh(float x) {
    const float y = 0.7978845608028654f * (x + 0.044715f * x * x * x);
    const float e = __expf(2.0f * y);
    const float th = 1.0f - 2.0f * __builtin_amdgcn_rcpf(e + 1.0f);
    return 0.5f * x * (1.0f + th);
}
__device__ __forceinline__ void cmp_unit(ldsp lds, int unit, const bf16_t* P, const bf16_t* PEb, const bf16_t* W1t, const float* b1, const bf16_t* W2t, bf16_t* OUT, int srccol) {
    int tid = threadIdx.x; asm volatile("" : "+v"(tid)); const int lane = tid & 63, w = __builtin_amdgcn_readfirstlane(tid >> 6), j = lane & 15, g = lane >> 4;
    const int ct = unit & 7, grp = (unit >> 3) & 1, b = unit >> 4;
    const ldsp CS = lds, CP = lds + 76032, CH = lds + 80640;
    const size_t rowb = (size_t)b * 4096;
    { u32x4 sv[9];
#pragma unroll
      for (int i = 0; i < 9; ++i) { const int idx = tid + 512 * i, tt = idx >> 3, ch = idx & 7, tok = 512 * ct + tt;
          sv[i] = (u32x4){0u, 0u, 0u, 0u}; if (idx < 528 * 8 && tok < 4096) sv[i] = *(const u32x4*)(P + (rowb + tok) * LDP + srccol + grp * 64 + ch * 8); }
#pragma unroll
      for (int i = 0; i < 9; ++i) { const int idx = tid + 512 * i, tt = idx >> 3, ch = idx & 7;
          if (idx < 528 * 8) *(LAS u32x4*)(CS + ((tt & 15) * 33 + (tt >> 4)) * P64 + ch * 16) = sv[i]; } }
    if (tid < 256) { const int l = tid >> 3, ch = tid & 7; *(LAS u32x4*)(CP + l * P64 + ch * 16) = *(const u32x4*)(PEb + (l * 2 + grp) * 64 + ch * 8); }
    __syncthreads();
    f32x4 acc[2][3];
#pragma unroll
    for (int a = 0; a < 2; ++a)
#pragma unroll
        for (int m = 0; m < 3; ++m) acc[a][m] = (f32x4){0.f, 0.f, 0.f, 0.f};
    const bf16_t* wrow0 = W1t + (size_t)(32 * w + j) * 2048 + 8 * g;
    const bf16_t* wrow1 = wrow0 + 16 * 2048;
    const bf16x8 zf = (bf16x8){0, 0, 0, 0, 0, 0, 0, 0};
#pragma unroll 8
    for (int l = 0; l < 32; ++l) {
#pragma unroll
        for (int s = 0; s < 2; ++s) {
            const bf16x8 w0 = *(const bf16x8*)(wrow0 + 64 * l + 32 * s), w1 = *(const bf16x8*)(wrow1 + 64 * l + 32 * s);
            const int rb = (l & 15) * 33 + (l >> 4) + j;
            const bf16x8 a0 = lds_rd16(CS + rb * P64 + 64 * s + 16 * g), a1 = lds_rd16(CS + (rb + 16) * P64 + 64 * s + 16 * g);
            bf16x8 pf = lds_rd16(CP + l * P64 + 64 * s + 16 * g); pf = (j == 0) ? pf : zf;
            acc[0][0] = MFMA16(w0, a0, acc[0][0]); acc[0][1] = MFMA16(w0, a1, acc[0][1]); acc[0][2] = MFMA16(w0, pf, acc[0][2]);
            acc[1][0] = MFMA16(w1, a0, acc[1][0]); acc[1][1] = MFMA16(w1, a1, acc[1][1]); acc[1][2] = MFMA16(w1, pf, acc[1][2]);
        }
    }
#pragma unroll
    for (int a = 0; a < 2; ++a) {
        const f32x4 bb = *(const f32x4*)(b1 + 32 * w + 16 * a + 4 * g);
        f32x4 bv;
#pragma unroll
        for (int e = 0; e < 4; ++e) bv[e] = __shfl(acc[a][2][e], lane & 48) + bb[e];
#pragma unroll
        for (int m = 0; m < 2; ++m) {
            const f32x4 x = acc[a][m] + bv;
            u32x2 o; o.x = cvt_pk_bf16(gelu_tanh(x[0]), gelu_tanh(x[1])); o.y = cvt_pk_bf16(gelu_tanh(x[2]), gelu_tanh(x[3]));
            *(LAS u32x2*)(CH + (16 * m + j) * 528 + (32 * w + 16 * a + 4 * g) * 2) = o;
        }
    }
    __syncthreads();
    { const int mt = w >> 2, dt = w & 3; f32x4 a2 = (f32x4){0.f, 0.f, 0.f, 0.f};
#pragma unroll
      for (int ks = 0; ks < 8; ++ks) {
          const bf16x8 wf = *(const bf16x8*)(W2t + (size_t)(16 * dt + j) * 256 + 32 * ks + 8 * g);
          const bf16x8 hf = lds_rd16(CH + (16 * mt + j) * 528 + (32 * ks + 8 * g) * 2);
          a2 = MFMA16(wf, hf, a2);
      }
      const int cidx = 32 * ct + 16 * mt + j;
      u32x2 o; o.x = cvt_pk_bf16(a2[0], a2[1]); o.y = cvt_pk_bf16(a2[2], a2[3]);
      *(u32x2*)(OUT + ((size_t)(b * 2 + grp) * 256 + cidx) * 64 + 16 * dt + 4 * g) = o; }
    __syncthreads();
}

constexpr int NS_KC = 0, NS_VC = 36864, NS_KB = 73728, NS_VB = 92160, NS_IMP = 110592, NS_UNI = 127232;
#define EX2(x) __builtin_amdgcn_exp2f(x)
template <int MODE> __device__ __forceinline__ void nsa_block(ldsp KB, ldsp VB, const bf16x8 (&q)[2][2], f32x4 (&o)[2][4], f32x4 (&lacc)[2], float (&mref)[2], bool first, int jb, int qi, int tl, bool rowsel, int j, int g, int r4, int cc) {
    f32x4 S[2][4];
    {
        bf16x8 kf[4][2];
#pragma unroll
        for (int kt = 0; kt < 4; ++kt)
#pragma unroll
            for (int s = 0; s < 2; ++s) kf[kt][s] = lds_rd16(KB + (16 * kt + j) * P64 + 64 * s + 16 * g);
        __builtin_amdgcn_s_setprio(1);
        const f32x4 z4 = (f32x4){0.f, 0.f, 0.f, 0.f};
#pragma unroll
        for (int qt = 0; qt < 2; ++qt)
#pragma unroll
            for (int kt = 0; kt < 4; ++kt) { f32x4 a = MFMA16(kf[kt][0], q[qt][0], z4); a = MFMA16(kf[kt][1], q[qt][1], a); S[qt][kt] = a; }
        __builtin_amdgcn_s_setprio(0);
    }
    if (__any(mref[0] != 0.f || mref[1] != 0.f)) {
#pragma unroll
        for (int qt = 0; qt < 2; ++qt)
#pragma unroll
            for (int kt = 0; kt < 4; ++kt) S[qt][kt] = S[qt][kt] - mref[qt];
    }
    if (jb == qi) {
#pragma unroll
        for (int qt = 0; qt < 2; ++qt)
#pragma unroll
            for (int kt = 0; kt < 4; ++kt)
#pragma unroll
                for (int e = 0; e < 4; ++e) S[qt][kt][e] = (16 * kt + 4 * g + e <= tl) ? S[qt][kt][e] : NEGB;
    }
    if (MODE == 1 && jb == qi - 8) {
#pragma unroll
        for (int qt = 0; qt < 2; ++qt)
#pragma unroll
            for (int kt = 0; kt < 4; ++kt)
#pragma unroll
                for (int e = 0; e < 4; ++e) S[qt][kt][e] = (16 * kt + 4 * g + e > tl) ? S[qt][kt][e] : NEGB;
    }
    float mx[2];
#pragma unroll
    for (int qt = 0; qt < 2; ++qt) {
        float m0 = __builtin_fmaxf(S[qt][0][0], S[qt][0][1]);
        float m1 = __builtin_fmaxf(S[qt][0][2], S[qt][0][3]);
#pragma unroll
        for (int kt = 1; kt < 4; ++kt) { m0 = __builtin_fmaxf(__builtin_fmaxf(m0, S[qt][kt][0]), S[qt][kt][1]); m1 = __builtin_fmaxf(__builtin_fmaxf(m1, S[qt][kt][2]), S[qt][kt][3]); }
        m0 = __builtin_fmaxf(m0, m1);
        if (MODE == 0) m0 = rowsel ? m0 : NEGB;
        mx[qt] = max_g(m0);
    }
    if (__any(fmaxf(mx[0], mx[1]) > 8.0f)) {
#pragma unroll
        for (int qt = 0; qt < 2; ++qt) {
            const float d = fmaxf(mx[qt], 0.f);
            const float alpha = EX2(-d); mref[qt] += d;
#pragma unroll
            for (int kt = 0; kt < 4; ++kt) S[qt][kt] = S[qt][kt] - d;
#pragma unroll
            for (int dt = 0; dt < 4; ++dt) o[qt][dt] = o[qt][dt] * alpha;
            lacc[qt] = lacc[qt] * alpha;
        }
    }
    __builtin_amdgcn_sched_barrier(0);
    bf16x8 vf[2][4];
#pragma unroll
    for (int u = 0; u < 2; ++u) { const int tr0 = 32 * u + 4 * g + r4;
#pragma unroll
        for (int dt = 0; dt < 4; ++dt) vf[u][dt] = cat4(lds_tr(VB + tr0 * P64 + (16 * dt + 4 * cc) * 2), lds_tr(VB + (tr0 + 16) * P64 + (16 * dt + 4 * cc) * 2)); }
    const short one = 0x3F80; const bf16x8 ones = (bf16x8){one, one, one, one, one, one, one, one};
#pragma unroll
    for (int qt = 0; qt < 2; ++qt) {
#pragma unroll
        for (int kt = 0; kt < 4; ++kt)
#pragma unroll
            for (int e = 0; e < 4; ++e) S[qt][kt][e] = EX2(S[qt][kt][e]);
#pragma unroll
        for (int u = 0; u < 2; ++u) {
            bf16x8 p = pack8(S[qt][2 * u], S[qt][2 * u + 1]);
            if (MODE == 0) { const bf16x8 z = (bf16x8){0, 0, 0, 0, 0, 0, 0, 0}; p = rowsel ? p : z; }
#pragma unroll
            for (int dt = 0; dt < 4; ++dt) o[qt][dt] = MFMA16(vf[u][dt], p, o[qt][dt]);
            lacc[qt] = MFMA16(ones, p, lacc[qt]);
        }
    }
    __builtin_amdgcn_sched_group_barrier(0x100, 16, 0);
    __builtin_amdgcn_sched_group_barrier(0x400, 16, 0);
    __builtin_amdgcn_sched_group_barrier(0x002, 12, 0);
#pragma unroll
    for (int i = 0; i < 10; ++i) { __builtin_amdgcn_sched_group_barrier(0x008, 1, 0); __builtin_amdgcn_sched_group_barrier(0x400, 2, 0); __builtin_amdgcn_sched_group_barrier(0x002, 2, 0); }
    __builtin_amdgcn_sched_group_barrier(0x008, 10, 0);
    __builtin_amdgcn_sched_barrier(0);
}

template <int MODE> __device__ __forceinline__ void nsa_branch(ldsp lds, const bf16_t* Kg, const bf16_t* Vg, const bf16x8 (&q)[2][2], f32x4 (&ofin)[2][4], const float (&gate)[2],
                                                               int qi, int tl, unsigned long long selm, unsigned long long unim, int jb0, int tid, int j, int g, int r4, int cc) {
    f32x4 o[2][4], lacc[2]; float mref[2] = {0.f, 0.f};
#pragma unroll
    for (int qt = 0; qt < 2; ++qt) { lacc[qt] = (f32x4){0.f, 0.f, 0.f, 0.f};
#pragma unroll
        for (int dt = 0; dt < 4; ++dt) o[qt][dt] = (f32x4){0.f, 0.f, 0.f, 0.f}; }
    const int kr = tid >> 3, kc8 = (tid & 7) * 8;
#define NXT(x) do { ++(x); while ((x) <= qi && !((unim >> (x)) & 1ull)) ++(x); } while (0)
#define LDKV(kd, vd, jj) do { if ((jj) <= qi) { kd = *(const u32x4*)(Kg + (size_t)(64 * (jj) + kr) * LDP + kc8); vd = *(const u32x4*)(Vg + (size_t)(64 * (jj) + kr) * LDP + kc8); } } while (0)
    int jb = jb0 - 1; NXT(jb);
    int jn = jb; NXT(jn);
    u32x4 k0 = (u32x4){0u, 0u, 0u, 0u}, v0 = k0, k1 = k0, v1 = k0;
    LDKV(k0, v0, jb); LDKV(k1, v1, jn);
    int buf = 0; bool first = true;
    while (jb <= qi) {
        const ldsp KB = lds + NS_KB + buf * 9216, VB = lds + NS_VB + buf * 9216;
        *(LAS u32x4*)(KB + kr * P64 + kc8 * 2) = k0; *(LAS u32x4*)(VB + kr * P64 + kc8 * 2) = v0;
        __syncthreads();
        int jnn = jn; NXT(jnn);
        k0 = k1; v0 = v1; LDKV(k1, v1, jnn);
        const bool rowsel = (MODE == 1) ? true : (((selm >> jb) & 1ull) != 0ull);
        nsa_block<MODE>(KB, VB, q, o, lacc, mref, first, jb, qi, tl, rowsel, j, g, r4, cc);
        jb = jn; jn = jnn; buf ^= 1; first = false;
    }
#undef NXT
#undef LDKV
#pragma unroll
    for (int qt = 0; qt < 2; ++qt) {
        const float ls = lacc[qt][0];
        const float sc = ls > 0.f ? gate[qt] / ls : 0.f;
#pragma unroll
        for (int dt = 0; dt < 4; ++dt) ofin[qt][dt] += o[qt][dt] * sc;
    }
    __syncthreads();
}

__device__ __forceinline__ bf16x8 scale8(bf16x8 v, float f) {
    const u32x4 w = __builtin_bit_cast(u32x4, v); u32x4 o;
    o.x = cvt_pk_bf16(bflo(w.x) * f, bfhi(w.x) * f); o.y = cvt_pk_bf16(bflo(w.y) * f, bfhi(w.y) * f); o.z = cvt_pk_bf16(bflo(w.z) * f, bfhi(w.z) * f); o.w = cvt_pk_bf16(bflo(w.w) * f, bfhi(w.w) * f);
    return __builtin_bit_cast(bf16x8, o);
}

__device__ __forceinline__ float sigmoid_f(float x) { return __builtin_amdgcn_rcpf(1.0f + __expf(-x)); }

__device__ __forceinline__ void nsa_unit(ldsp lds, int b, int grp, int qi, const bf16_t* P, const bf16_t* QR, const bf16_t* KCMP, const bf16_t* VCMP, bf16_t* MIX) {
    int tid = threadIdx.x; asm volatile("" : "+v"(tid)); const int lane = tid & 63, w = __builtin_amdgcn_readfirstlane(tid >> 6), j = lane & 15, g = lane >> 4, r4 = j >> 2, cc = lane & 3;
    const size_t rowbase = (size_t)b * 4096;
    const int nu = (((4 * qi + 3 + 15) >> 4) + 1) >> 1;
    { const bf16_t* kc = KCMP + (size_t)(b * 2 + grp) * 256 * 64; const bf16_t* vc = VCMP + (size_t)(b * 2 + grp) * 256 * 64;
      u32x4 ck[4], cv[4];
#pragma unroll
      for (int i = 0; i < 4; ++i) { const int idx = tid + 512 * i; if (idx < 32 * nu * 8) { ck[i] = *(const u32x4*)(kc + (size_t)idx * 8); cv[i] = *(const u32x4*)(vc + (size_t)idx * 8); } }
#pragma unroll
      for (int i = 0; i < 4; ++i) { const int idx = tid + 512 * i, r = idx >> 3, ch = idx & 7; if (idx < 32 * nu * 8) { *(LAS u32x4*)(lds + NS_KC + r * P64 + ch * 16) = ck[i]; *(LAS u32x4*)(lds + NS_VC + r * P64 + ch * 16) = cv[i]; } } }
    const int tl = 8 * w + (j & 7), t = qi * 64 + tl;
    const size_t row = rowbase + t;
    const int hg0 = 4 * grp + (j >> 3);
    float gates[3][2];
#pragma unroll
    for (int qt = 0; qt < 2; ++qt)
#pragma unroll
        for (int x = 0; x < 3; ++x) gates[x][qt] = sigmoid_f(__uint_as_float((unsigned)P[row * LDP + 2816 + (hg0 + 2 * qt) * 3 + x] << 16));
    bf16x8 q[2][2];
#pragma unroll
    for (int qt = 0; qt < 2; ++qt)
#pragma unroll
        for (int s = 0; s < 2; ++s) q[qt][s] = scale8(*(const bf16x8*)(P + row * LDP + 1536 + (hg0 + 2 * qt) * 64 + 32 * s + 8 * g), C2);
    __syncthreads();
    f32x4 ofin[2][4];
    LAS float* impl = (LAS float*)(lds + NS_IMP) + w * 8 * 65;
    unsigned selLo = 0u, selHi = 0u, uniLo = 0u, uniHi = 0u;
#ifndef NSA_REP_CMP
#define NSA_REP_CMP 1
#endif
    for (int rep_ = 0; rep_ < NSA_REP_CMP; ++rep_) {
    for (int i = lane; i < 8 * 65; i += 64) impl[i] = 0.f;
    const int nvalid = (t >= 31) ? ((t - 15) >> 4) : 0;
    {
        f32x4 oc[2][4];
#pragma unroll
        for (int qt = 0; qt < 2; ++qt)
#pragma unroll
            for (int dt = 0; dt < 4; ++dt) oc[qt][dt] = (f32x4){0.f, 0.f, 0.f, 0.f};
        float cref[2] = {0.f, 0.f}, lsum[2] = {0.f, 0.f}, prev[2] = {0.f, 0.f};
        float ia[2][8], ib[2][8];
#pragma unroll
        for (int qt = 0; qt < 2; ++qt)
#pragma unroll
            for (int u = 0; u < 8; ++u) { ia[qt][u] = 0.f; ib[qt][u] = 0.f; }
        const f32x4 z4 = (f32x4){0.f, 0.f, 0.f, 0.f};
#pragma unroll
        for (int u = 0; u < 8; ++u) {
            if (u < nu) {
                const bf16x8 ka0 = lds_rd16(lds + NS_KC + (32 * u + j) * P64 + 16 * g), ka1 = lds_rd16(lds + NS_KC + (32 * u + j) * P64 + 64 + 16 * g);
                const bf16x8 kb0 = lds_rd16(lds + NS_KC + (32 * u + 16 + j) * P64 + 16 * g), kb1 = lds_rd16(lds + NS_KC + (32 * u + 16 + j) * P64 + 64 + 16 * g);
                const int tr0 = 32 * u + 4 * g + r4;
                bf16x8 vf[4];
#pragma unroll
                for (int dt = 0; dt < 4; ++dt) vf[dt] = cat4(lds_tr(lds + NS_VC + tr0 * P64 + (16 * dt + 4 * cc) * 2), lds_tr(lds + NS_VC + (tr0 + 16) * P64 + (16 * dt + 4 * cc) * 2));
                f32x4 s0[2], s1[2]; float mloc[2];
#pragma unroll
                for (int qt = 0; qt < 2; ++qt) {
                    s0[qt] = MFMA16(ka0, q[qt][0], z4); s0[qt] = MFMA16(ka1, q[qt][1], s0[qt]); s1[qt] = MFMA16(kb0, q[qt][0], z4); s1[qt] = MFMA16(kb1, q[qt][1], s1[qt]);
                    float ml = NEGB;
#pragma unroll
                    for (int e = 0; e < 4; ++e) { const int c0 = 32 * u + 4 * g + e; s0[qt][e] = (c0 < nvalid) ? s0[qt][e] - cref[qt] : NEGB; s1[qt][e] = (c0 + 16 < nvalid) ? s1[qt][e] - cref[qt] : NEGB;
                        ml = __builtin_fmaxf(__builtin_fmaxf(ml, s0[qt][e]), s1[qt][e]); }
                    mloc[qt] = ml;
                }
                if (__any(fmaxf(mloc[0], mloc[1]) > 8.0f)) {
#pragma unroll
                    for (int qt = 0; qt < 2; ++qt) {
                        const float d = fmaxf(max_g(mloc[qt]), 0.f), alpha = EX2(-d); cref[qt] += d;
                        s0[qt] = s0[qt] - d; s1[qt] = s1[qt] - d; lsum[qt] *= alpha; prev[qt] *= alpha;
#pragma unroll
                        for (int dt = 0; dt < 4; ++dt) oc[qt][dt] = oc[qt][dt] * alpha;
#pragma unroll
                        for (int v = 0; v < 8; ++v) { ia[qt][v] *= alpha; ib[qt][v] *= alpha; }
                    }
                }
#pragma unroll
                for (int qt = 0; qt < 2; ++qt) {
#pragma unroll
                    for (int e = 0; e < 4; ++e) { s0[qt][e] = EX2(s0[qt][e]); s1[qt][e] = EX2(s1[qt][e]); }
                    lsum[qt] += ((s0[qt][0] + s0[qt][1]) + (s0[qt][2] + s0[qt][3])) + ((s1[qt][0] + s1[qt][1]) + (s1[qt][2] + s1[qt][3]));
                    float own0 = (s0[qt][0] + s0[qt][1]) + (s0[qt][2] + 0.5f * s0[qt][3]), own1 = (s1[qt][0] + s1[qt][1]) + (s1[qt][2] + 0.5f * s1[qt][3]);
                    const float car0 = 0.5f * s0[qt][3], car1 = 0.5f * s1[qt][3];
                    const float t0 = __shfl(car0, (lane + 48) & 63), t1 = __shfl(car1, (lane + 48) & 63);
                    own0 += (g == 0) ? prev[qt] : t0; own1 += (g == 0) ? t0 : t1; prev[qt] = t1;
                    ia[qt][u] = own0; ib[qt][u] = own1;
                    const bf16x8 pf = pack8(s0[qt], s1[qt]);
#pragma unroll
                    for (int dt = 0; dt < 4; ++dt) oc[qt][dt] = MFMA16(vf[dt], pf, oc[qt][dt]);
                }
            }
        }
        float inv[2];
#pragma unroll
        for (int qt = 0; qt < 2; ++qt) { const float lt = sum_g(lsum[qt]); inv[qt] = lt > 0.f ? 1.0f / lt : 0.f;
#pragma unroll
            for (int dt = 0; dt < 4; ++dt) ofin[qt][dt] = oc[qt][dt] * (inv[qt] * gates[0][qt]); }
#pragma unroll
        for (int u = 0; u < 8; ++u) {
            if (u < nu) {
                float a0 = ia[0][u] * inv[0] + ia[1][u] * inv[1], a1 = ib[0][u] * inv[0] + ib[1][u] * inv[1];
                a0 += xswz<8>(a0); a1 += xswz<8>(a1);
                if (j < 8) { impl[j * 65 + 8 * u + g] = a0; impl[j * 65 + 8 * u + 4 + g] = a1; }
            }
        }
    }
    if (qi < 16) {
        selLo = uniLo = (1u << (qi + 1)) - 1u; selHi = uniHi = 0u;
    } else {
        LAS unsigned* impu = (LAS unsigned*)impl;
        const int tok = lane >> 3, sub = lane & 7;
        unsigned myk[8]; int rank[8];
#pragma unroll
        for (int k = 0; k < 8; ++k) { const int s = sub + 8 * k; const bool forced = (s == 0) || (s == qi) || (s == qi - 1); const float v = impl[tok * 65 + s] + (forced ? 1e4f : 0.f);
            myk[k] = (s <= qi) ? ((__float_as_uint(v) & 0xFFFFFFC0u) | (unsigned)(63 - s)) : 0u; rank[k] = 0; }
#pragma unroll
        for (int k = 0; k < 8; ++k) impu[tok * 65 + sub + 8 * k] = myk[k];
#pragma unroll 8
        for (int sp = 0; sp < 64; ++sp) { const unsigned v = impu[tok * 65 + sp];
#pragma unroll
            for (int k = 0; k < 8; ++k) rank[k] += (v > myk[k]) ? 1 : 0; }
        unsigned mlo = 0u, mhi = 0u;
#pragma unroll
        for (int k = 0; k < 8; ++k) { const int s = sub + 8 * k; const bool sel = (rank[k] < 16) && (s <= qi); if (sel) { if (k < 4) mlo |= 1u << s; else mhi |= 1u << (s - 32); } }
        mlo |= xswzu<1>(mlo); mhi |= xswzu<1>(mhi); mlo |= xswzu<2>(mlo); mhi |= xswzu<2>(mhi); mlo |= xswzu<4>(mlo); mhi |= xswzu<4>(mhi);
        selLo = __shfl(mlo, (lane & 7) * 8); selHi = __shfl(mhi, (lane & 7) * 8);
        unsigned ulo = mlo, uhi = mhi;
        ulo |= xswzu<8>(ulo); uhi |= xswzu<8>(uhi); ulo |= xswzu<16>(ulo); uhi |= xswzu<16>(uhi); ulo = or_x32(ulo); uhi = or_x32(uhi);
        LAS unsigned* uni = (LAS unsigned*)(lds + NS_UNI);
        if (lane == 0) { uni[2 * w] = ulo; uni[2 * w + 1] = uhi; }
        __syncthreads();
        unsigned a = 0u, bq = 0u;
#pragma unroll
        for (int k = 0; k < 8; ++k) { a |= uni[2 * k]; bq |= uni[2 * k + 1]; }
        uniLo = __builtin_amdgcn_readfirstlane(a); uniHi = __builtin_amdgcn_readfirstlane(bq);
    }
    }
#pragma unroll
    for (int qt = 0; qt < 2; ++qt)
#pragma unroll
        for (int s = 0; s < 2; ++s) q[qt][s] = scale8(*(const bf16x8*)(QR + row * 512 + (hg0 + 2 * qt) * 64 + 32 * s + 8 * g), C2);
    { const float gsel[2] = {gates[1][0], gates[1][1]};
      nsa_branch<0>(lds, P + rowbase * LDP + 2304 + grp * 64, P + rowbase * LDP + 2432 + grp * 64, q, ofin, gsel, qi, tl, ((unsigned long long)selHi << 32) | selLo, ((unsigned long long)uniHi << 32) | uniLo, 0, tid, j, g, r4, cc); }
    { const float gwin[2] = {gates[2][0], gates[2][1]};
      nsa_branch<1>(lds, P + rowbase * LDP + 2560 + grp * 64, P + rowbase * LDP + 2688 + grp * 64, q, ofin, gwin, qi, tl, ~0ull, ~0ull, (qi >= 8 ? qi - 8 : 0), tid, j, g, r4, cc); }
#pragma unroll
    for (int qt = 0; qt < 2; ++qt)
#pragma unroll
        for (int dt = 0; dt < 4; ++dt) { u32x2 o; o.x = cvt_pk_bf16(ofin[qt][dt][0], ofin[qt][dt][1]); o.y = cvt_pk_bf16(ofin[qt][dt][2], ofin[qt][dt][3]);
            *(u32x2*)(MIX + row * 1024 + 512 + (hg0 + 2 * qt) * 64 + 16 * dt + 4 * g) = o; }
    __syncthreads();
}
#define XB_TMO      128
#define XB_XCNT(j)  (256  + 64 * (j))
#define XB_XSUB(j)  (1280 + 64 * (j))
#define XB_XGEN(j)  (2304 + 64 * (j))
#define XB_TOP      3328
#define XB_TOPGEN   3392
#define XCD_BAR_WORDS 3456
#define XB_SPIN_CAP (1u << 18)

__device__ __forceinline__ unsigned xb_ld(unsigned* p)              { return __hip_atomic_load(p, __ATOMIC_RELAXED, __HIP_MEMORY_SCOPE_AGENT); }
__device__ __forceinline__ unsigned xb_add(unsigned* p, unsigned v) { return __hip_atomic_fetch_add(p, v, __ATOMIC_RELAXED, __HIP_MEMORY_SCOPE_AGENT); }
__device__ __forceinline__ unsigned xb_xcc_id() { return (unsigned)__builtin_amdgcn_s_getreg((3 << 11) | 20) & 0xFu; }
#define XB_SPIN(cond, bar) do { unsigned _sp = 0; while (cond) { __builtin_amdgcn_s_sleep(1); \
    if ((++_sp & 255u) == 0u) { if (xb_ld(&(bar)[XB_TMO])) break; if (_sp > XB_SPIN_CAP) { atomicAdd(&(bar)[XB_TMO], 1u); break; } } } } while (0)

struct XcdBarrier {
    unsigned* bar; unsigned x;
    volatile LAS unsigned* st;
};

__device__ __forceinline__ XcdBarrier xcd_barrier_post(unsigned* bar, volatile LAS unsigned* st) {
    XcdBarrier b; b.bar = bar; b.x = xb_xcc_id(); b.st = st;
    if (threadIdx.x == 0) (void)xb_add(&bar[XB_XCNT(b.x)], 1u);
    return b;
}
__device__ __forceinline__ void xcd_barrier_complete(unsigned* bar, unsigned x, unsigned& nloc, unsigned& nx) {
    const unsigned G = gridDim.x * gridDim.y * gridDim.z;
    unsigned sum, cnt, mine, sp = 0u;
    for (;;) {
        sum = 0u; cnt = 0u; mine = 0u;
#pragma unroll
        for (unsigned j = 0; j < 16; ++j) { const unsigned c = xb_ld(&bar[XB_XCNT(j)]); sum += c; cnt += (c > 0u) ? 1u : 0u; mine = (j == x) ? c : mine; }
        if (sum == G) break;
        __builtin_amdgcn_s_sleep(1);
        if ((++sp & 255u) == 0u) { if (xb_ld(&bar[XB_TMO])) break; if (sp > XB_SPIN_CAP) { atomicAdd(&bar[XB_TMO], 1u); break; } }
    }
    nloc = mine > 0u ? mine : 1u; nx = cnt > 0u ? cnt : 1u;
}

__device__ __forceinline__ void xcd_barrier(const XcdBarrier& b) {
    asm volatile("s_waitcnt vmcnt(0)" ::: "memory");
    __syncthreads();
    if (threadIdx.x == 0) {
        unsigned* bar = b.bar;
        __builtin_amdgcn_s_waitcnt(0);
        unsigned nloc = b.st[0], nx = b.st[1];
        if (nloc == 0u) { xcd_barrier_complete(bar, b.x, nloc, nx); b.st[0] = nloc; b.st[1] = nx; }
        const unsigned old = xb_add(&bar[XB_XSUB(b.x)], 1u);
        const unsigned gen = old / nloc;
        if (old + 1u == (gen + 1u) * nloc) {
            __builtin_amdgcn_fence(__ATOMIC_RELEASE, "agent");
            asm volatile("s_waitcnt vmcnt(0)" ::: "memory");
            const unsigned og = xb_add(&bar[XB_TOP], 1u);
            const unsigned tg = og / nx;
            if (og + 1u == (tg + 1u) * nx) xb_add(&bar[XB_TOPGEN], 1u);
            else XB_SPIN(xb_ld(&bar[XB_TOPGEN]) == tg, bar);
            __builtin_amdgcn_fence(__ATOMIC_ACQUIRE, "agent");
            xb_add(&bar[XB_XGEN(b.x)], 1u);
            asm volatile("s_waitcnt vmcnt(0)" ::: "memory");
        } else {
            XB_SPIN(xb_ld(&bar[XB_XGEN(b.x)]) == gen, bar);
            __builtin_amdgcn_fence(__ATOMIC_ACQUIRE, "agent");
            asm volatile("s_waitcnt vmcnt(0)" ::: "memory");
        }
    }
    __syncthreads();
}
#ifndef MK_PER_PHASE
#define MK_PER_PHASE 0
#endif
constexpr int M = 32768, D = 1024, DFF = 2816, NGU = 5632, NIN = 3072, NINV = 2840;
constexpr size_t MiB = 1u << 20;
constexpr size_t WS_SSQ = 0;
constexpr size_t WS_ROPER = 1 * MiB, WS_ROPEN = 2 * MiB, WS_PE = 2 * MiB + 512 * 1024;
constexpr size_t WS_W1K = 3 * MiB, WS_W1V = 4 * MiB, WS_W2K = 5 * MiB, WS_W2V = 5 * MiB + 65536;
constexpr size_t WS_KCMP = 6 * MiB, WS_VCMP = 6 * MiB + 512 * 1024;
constexpr size_t WS_WGU1 = 8 * MiB, WS_WD1 = 20 * MiB, WS_WIN = 26 * MiB, WS_WOUT = 32 * MiB, WS_WGU2 = 34 * MiB, WS_WD2 = 46 * MiB;
constexpr size_t WS_STATE = 52 * MiB, WS_HB = 84 * MiB, WS_XB = 148 * MiB, WS_QROT = 212 * MiB, WS_BIG = 244 * MiB, WS_END = 436 * MiB;
constexpr size_t WS_CTL = 7 * MiB, CTL_BYTES = 65536;
constexpr int LDS_BYTES = 147456, MISC_OFF = 131072;
constexpr int NPHASE = 11;
#ifndef SKIPMASK
#define SKIPMASK 0
#endif
#ifndef WGM_N4
#define WGM_N4 8
#endif
#ifndef REPMASK
#define REPMASK 0
#endif

struct Args { const float* in[22]; float* out; unsigned char* ws; int ph_lo, ph_hi; };

__device__ __forceinline__ float wave_sum(float v) {
#pragma unroll
    for (int o = 1; o < 64; o <<= 1) v += __shfl_xor(v, o);
    return v;
}
__device__ __forceinline__ unsigned f2bf(float f) { unsigned u = __builtin_bit_cast(unsigned, f); return (u + 0x7fffu + ((u >> 16) & 1u)) >> 16; }
__device__ __forceinline__ unsigned pk2(float lo, float hi) { return f2bf(lo) | (f2bf(hi) << 16); }

__device__ __forceinline__ int rowmap(int mode, int n) {
    if (mode == 1) return 256 * (n >> 7) + (n & 127);
    if (mode == 2) return 256 * (n >> 7) + 128 + (n & 127);
    if (mode == 3 && n < 512) { const int hb = n >> 6, d = n & 63, dd = d & 31; return hb * 64 + 8 * (dd >> 2) + (d >= 32 ? 4 : 0) + (dd & 3); }
    return n;
}
__device__ __forceinline__ void p0_transpose_item(const float* W, int K, int ldw, int nvalid, const float* kscale, bf16_t* WT, int mode, LAS float* scr, int nblk, int item, int lane) {
    const int kb = item / nblk, nb = item % nblk, k0 = 64 * kb, n0 = 32 * nb;
    { const int kr = lane >> 3, c4 = (lane & 7) * 4; const bool ok = (n0 + c4) < nvalid;
      f32x4 v[8];
#pragma unroll
      for (int i = 0; i < 8; ++i) v[i] = ok ? *(const f32x4*)(W + (size_t)(k0 + kr + 8 * i) * ldw + n0 + c4) : (f32x4){0.f, 0.f, 0.f, 0.f};
#pragma unroll
      for (int i = 0; i < 8; ++i) { const int kk = kr + 8 * i; const float sc = kscale ? kscale[k0 + kk] : 1.0f;
          scr[kk * 33 + c4 + 0] = v[i][0] * sc; scr[kk * 33 + c4 + 1] = v[i][1] * sc; scr[kk * 33 + c4 + 2] = v[i][2] * sc; scr[kk * 33 + c4 + 3] = v[i][3] * sc; } }
    asm volatile("s_waitcnt lgkmcnt(0)" ::: "memory");
    const int c = lane & 7;
#pragma unroll
    for (int jj = 0; jj < 4; ++jj) { const int nn = (lane >> 3) + 8 * jj; const LAS float* s = scr + (8 * c) * 33 + nn;
        u32x4 o; o.x = pk2(s[0 * 33], s[1 * 33]); o.y = pk2(s[2 * 33], s[3 * 33]); o.z = pk2(s[4 * 33], s[5 * 33]); o.w = pk2(s[6 * 33], s[7 * 33]);
        *(u32x4*)(WT + (size_t)rowmap(mode, n0 + nn) * K + k0 + 8 * c) = o; }
    asm volatile("s_waitcnt lgkmcnt(0)" ::: "memory");
}

__global__ void __launch_bounds__(512, 2) mega_fwd(Args a) {
    extern __shared__ __attribute__((aligned(16))) unsigned char lds_raw[];
    ldsp lds = (ldsp)lds_raw;
    cg::grid_group grid = cg::this_grid();
    const int tid = threadIdx.x, lane = tid & 63, wave = __builtin_amdgcn_readfirstlane(tid >> 6);
    const int G = gridDim.x, bx = blockIdx.x;
    const int lo = a.ph_lo, hi = a.ph_hi;
    unsigned char* ws = a.ws;
    float* ssq0 = (float*)(ws + WS_SSQ); float* ssq1 = ssq0 + M; float* ssq2 = ssq1 + M; float* ssq3 = ssq2 + M;
    float* ropeR = (float*)(ws + WS_ROPER); float* ropeN = (float*)(ws + WS_ROPEN);
    bf16_t* PEb = (bf16_t*)(ws + WS_PE);
    bf16_t* HB = (bf16_t*)(ws + WS_HB); bf16_t* XB = (bf16_t*)(ws + WS_XB); bf16_t* QROT = (bf16_t*)(ws + WS_QROT); bf16_t* BIG = (bf16_t*)(ws + WS_BIG);
    float* ST = (float*)(ws + WS_STATE);
    bf16_t* KCMP = (bf16_t*)(ws + WS_KCMP); bf16_t* VCMP = (bf16_t*)(ws + WS_VCMP);
    float* out = a.out;
    volatile LAS unsigned* MISC = (volatile LAS unsigned*)(lds + MISC_OFF);
    if (tid < 16) MISC[tid] = 0u;
    __syncthreads();
    XcdBarrier bar = xcd_barrier_post((unsigned*)(ws + WS_CTL), MISC + 8);
#define IN(k) (lo <= (k) && (k) < hi)
#define SEAM(k) do { if (IN(k) && IN((k) + 1)) { if (lo < 0) grid.sync(); else xcd_barrier(bar); } } while (0)

    if (IN(0) && !(SKIPMASK & (1 << 0))) {
        for (int rep = 0; rep < (REPMASK & 1) + 1; ++rep) {
        LAS float* scr = (LAS float*)(lds + wave * 16384);
        const int gw = bx * 8 + wave, NGW = G * 8;
        constexpr int I_G = 16 * 88, I_D = 44 * 32, I_IN = 16 * 96, I_O = 16 * 32, I_C1 = 32 * 8, I_C2 = 4 * 2;
        constexpr int NITEMS = 4 * I_G + 2 * I_D + I_IN + I_O + 2 * I_C1 + 2 * I_C2;
        for (int it = gw; it < NITEMS; it += NGW) {
            int r = it;
            if (r < I_G) { p0_transpose_item(a.in[2], 1024, DFF, DFF, a.in[1], (bf16_t*)(ws + WS_WGU1), 1, scr, 88, r, lane); continue; } r -= I_G;
            if (r < I_G) { p0_transpose_item(a.in[3], 1024, DFF, DFF, a.in[1], (bf16_t*)(ws + WS_WGU1), 2, scr, 88, r, lane); continue; } r -= I_G;
            if (r < I_D) { p0_transpose_item(a.in[4], DFF, 1024, 1024, nullptr, (bf16_t*)(ws + WS_WD1), 0, scr, 32, r, lane); continue; } r -= I_D;
            if (r < I_IN) { p0_transpose_item(a.in[6], 1024, NINV, NINV, a.in[5], (bf16_t*)(ws + WS_WIN), 3, scr, 96, r, lane); continue; } r -= I_IN;
            if (r < I_O) { p0_transpose_item(a.in[16], 1024, 1024, 1024, nullptr, (bf16_t*)(ws + WS_WOUT), 0, scr, 32, r, lane); continue; } r -= I_O;
            if (r < I_G) { p0_transpose_item(a.in[18], 1024, DFF, DFF, a.in[17], (bf16_t*)(ws + WS_WGU2), 1, scr, 88, r, lane); continue; } r -= I_G;
            if (r < I_G) { p0_transpose_item(a.in[19], 1024, DFF, DFF, a.in[17], (bf16_t*)(ws + WS_WGU2), 2, scr, 88, r, lane); continue; } r -= I_G;
            if (r < I_D) { p0_transpose_item(a.in[20], DFF, 1024, 1024, nullptr, (bf16_t*)(ws + WS_WD2), 0, scr, 32, r, lane); continue; } r -= I_D;
            if (r < I_C1) { p0_transpose_item(a.in[9], 2048, 256, 256, nullptr, (bf16_t*)(ws + WS_W1K), 0, scr, 8, r, lane); continue; } r -= I_C1;
            if (r < I_C1) { p0_transpose_item(a.in[13], 2048, 256, 256, nullptr, (bf16_t*)(ws + WS_W1V), 0, scr, 8, r, lane); continue; } r -= I_C1;
            if (r < I_C2) { p0_transpose_item(a.in[11], 256, 64, 64, nullptr, (bf16_t*)(ws + WS_W2K), 0, scr, 2, r, lane); continue; } r -= I_C2;
            p0_transpose_item(a.in[15], 256, 64, 64, nullptr, (bf16_t*)(ws + WS_W2V), 0, scr, 2, r, lane);
        }
        const int gt = bx * 512 + tid, NGT = G * 512;
        for (int i = gt; i < 4096; i += NGT) { PEb[i] = (bf16_t)f2bf(a.in[8][i]); PEb[4096 + i] = (bf16_t)f2bf(a.in[12][i]); }
        for (int i = gt; i < 3 * M; i += NGT) ssq1[i] = 0.f;
        const float* x = a.in[0];
        for (int m = gw; m < M; m += 2 * NGW) {
            const int m2 = m + NGW; const bool has2 = m2 < M;
            const f32x4* xr = (const f32x4*)(x + (size_t)m * D) + lane; const f32x4* xr2 = (const f32x4*)(x + (size_t)(has2 ? m2 : m) * D) + lane;
            f32x4 v[4], v2[4]; float s = 0.f, s2 = 0.f;
#pragma unroll
            for (int jj = 0; jj < 4; ++jj) { v[jj] = xr[64 * jj]; v2[jj] = xr2[64 * jj]; }
#pragma unroll
            for (int jj = 0; jj < 4; ++jj) { s += (v[jj][0] * v[jj][0] + v[jj][1] * v[jj][1]) + (v[jj][2] * v[jj][2] + v[jj][3] * v[jj][3]);
                                             s2 += (v2[jj][0] * v2[jj][0] + v2[jj][1] * v2[jj][1]) + (v2[jj][2] * v2[jj][2] + v2[jj][3] * v2[jj][3]); }
            s = wave_sum(s); s2 = wave_sum(s2);
            { const float r1 = __builtin_amdgcn_rsqf(s * (1.0f / 1024.0f) + 1e-6f), r2 = __builtin_amdgcn_rsqf(s2 * (1.0f / 1024.0f) + 1e-6f);
#pragma unroll
              for (int jj = 0; jj < 4; ++jj) { v[jj] = v[jj] * r1; v2[jj] = v2[jj] * r2; } }
            u32x2* o8 = (u32x2*)(XB + (size_t)m * D) + lane; u32x2* o82 = (u32x2*)(XB + (size_t)(has2 ? m2 : m) * D) + lane;
#pragma unroll
            for (int jj = 0; jj < 4; ++jj) { u32x2 o; o.x = cvt_pk_bf16(v[jj][0], v[jj][1]); o.y = cvt_pk_bf16(v[jj][2], v[jj][3]); o8[64 * jj] = o;
                if (has2) { u32x2 o2; o2.x = cvt_pk_bf16(v2[jj][0], v2[jj][1]); o2.y = cvt_pk_bf16(v2[jj][2], v2[jj][3]); o82[64 * jj] = o2; } }
        }
        }
        __syncthreads();
    }
    SEAM(0);
    if (REPMASK & 1024) { for (int k = 0; k < 10; ++k) grid.sync(); }
    if (IN(1) && !(SKIPMASK & (1 << 1))) { pg8::Gemm g{XB, (const bf16_t*)(ws + WS_WGU1), M, NGU, 1024}; pg8::StaticOrder S; S.init(M, NGU, G, bx);
        pg8::EpiGateUp<false> E{BIG, DFF, nullptr};
        pg8::gemm_phase<pg8::EpiGateUp<false>, pg8::StaticOrder, true, true>(lds, g, S, E);
        if (REPMASK & 2) pg8::gemm_phase<pg8::EpiGateUp<false>, pg8::StaticOrder, true, true>(lds, g, S, E); }
    SEAM(1);
    if (IN(2) && !(SKIPMASK & (1 << 2))) { pg8::Gemm g{BIG, (const bf16_t*)(ws + WS_WD1), M, 1024, DFF}; pg8::StaticOrder S; S.init(M, 1024, G, bx, WGM_N4);
        pg8::EpiResid<true> E{a.in[0], HB, ssq1, 0.5f, (REPMASK & 4) ? 0.5f : 1.0f};
        pg8::gemm_phase<pg8::EpiResid<true>, pg8::StaticOrder, true, true>(lds, g, S, E);
        if (REPMASK & 4) pg8::gemm_phase<pg8::EpiResid<true>, pg8::StaticOrder, true, true>(lds, g, S, E); }
    SEAM(2);
    if (IN(3) && !(SKIPMASK & (1 << 3))) { pg8::Gemm g{HB, (const bf16_t*)(ws + WS_WIN), M, NIN, 1024}; pg8::StaticOrder S; S.init(M, NIN, G, bx);
        pg8::EpiIn E{BIG, QROT, ssq1};
        pg8::gemm_phase<pg8::EpiIn, pg8::StaticOrder, true, true>(lds, g, S, E);
        if (REPMASK & 8) pg8::gemm_phase<pg8::EpiIn, pg8::StaticOrder, true, true>(lds, g, S, E); }
    SEAM(3);
    if (IN(4) && !(SKIPMASK & (1 << 4))) {
        for (int rep = 0; rep < ((REPMASK >> 4) & 1) + 1; ++rep)
        for (int u = bx; u < 1280; u += G) {
            if (u < 256) { const int kv = u >> 7;
                cmp_unit(lds, u & 127, BIG, PEb + kv * 4096, (const bf16_t*)(ws + (kv ? WS_W1V : WS_W1K)), a.in[kv ? 14 : 10], (const bf16_t*)(ws + (kv ? WS_W2V : WS_W2K)), kv ? VCMP : KCMP, kv ? 2176 : 2048); }
            else ret_u_unit(lds, u - 256, BIG, ST);
        }
    }
    SEAM(4);
    if (IN(5) && !(SKIPMASK & (1 << 5))) {
        unsigned* qctr = (unsigned*)(ws + WS_CTL) + 3584;
        unsigned* sctr = (unsigned*)(ws + WS_CTL) + 3648;
        constexpr int NSCAN = 64, U_NSA = NSCAN, U_RET = NSCAN + 1024, U_END = NSCAN + 2048;
        bool scan_ok = false;
        if (tid == 0) MISC[0] = __hip_atomic_fetch_add(qctr, 1u, __ATOMIC_RELAXED, __HIP_MEMORY_SCOPE_AGENT);
        __syncthreads();
        int u = __builtin_amdgcn_readfirstlane((int)MISC[0]);
        while (u < U_END) {
            unsigned nxt = 0u; if (tid == 0) nxt = __hip_atomic_fetch_add(qctr, 1u, __ATOMIC_RELAXED, __HIP_MEMORY_SCOPE_AGENT);
            if (u < U_NSA) {
                const int idx0 = u * 4096 + tid; const int bh = idx0 >> 13; const float gc = exp2f(128.0f * ret_log2g(bh & 3));
                float* p = ST + ((size_t)bh * 32 << 13) + (idx0 & 8191);
                float run[8];
#pragma unroll
                for (int k = 0; k < 8; ++k) run[k] = 0.f;
#pragma unroll 4
                for (int c = 0; c < 32; ++c) {
                    float uu[8];
#pragma unroll
                    for (int k = 0; k < 8; ++k) uu[k] = p[((size_t)c << 13) + 512 * k];
#pragma unroll
                    for (int k = 0; k < 8; ++k) { p[((size_t)c << 13) + 512 * k] = run[k]; run[k] = gc * run[k] + uu[k]; }
                }
                asm volatile("s_waitcnt vmcnt(0)" ::: "memory");
                __syncthreads();
                if (tid == 0) { __builtin_amdgcn_fence(__ATOMIC_RELEASE, "agent"); __hip_atomic_fetch_add(sctr, 1u, __ATOMIC_RELAXED, __HIP_MEMORY_SCOPE_AGENT); }
            } else if (u < U_RET) { const int v = u - U_NSA, qi = 63 - (v >> 4), bg = v & 15; nsa_unit(lds, bg >> 1, bg & 1, qi, BIG, QROT, KCMP, VCMP, XB); }
            else {
                if (!scan_ok) {
                    if (tid == 0) { unsigned sp = 0; while (__hip_atomic_load(sctr, __ATOMIC_RELAXED, __HIP_MEMORY_SCOPE_AGENT) < (unsigned)NSCAN) { __builtin_amdgcn_s_sleep(2); if (++sp > (1u << 22)) break; }
                                    __builtin_amdgcn_fence(__ATOMIC_ACQUIRE, "agent"); }
                    asm volatile("s_waitcnt vmcnt(0)" ::: "memory");
                    __syncthreads();
                    __builtin_amdgcn_fence(__ATOMIC_ACQUIRE, "agent");
                    scan_ok = true;
                }
                ret_out_unit(lds, u - U_RET, BIG, ST, a.in[7], XB);
            }
            if (tid == 0) MISC[0] = nxt;
            __syncthreads();
            u = __builtin_amdgcn_readfirstlane((int)MISC[0]);
        }
    }
    SEAM(5);
    if (IN(7) && !(SKIPMASK & (1 << 7))) { pg8::Gemm g{XB, (const bf16_t*)(ws + WS_WOUT), M, 1024, 1024}; pg8::StaticOrder S; S.init(M, 1024, G, bx, WGM_N4);
        pg8::EpiResid<false> E{nullptr, HB, ssq2, 1.0f, 1.0f};
        pg8::gemm_phase<pg8::EpiResid<false>, pg8::StaticOrder, true, true>(lds, g, S, E); }
    SEAM(7);
    if (IN(8) && !(SKIPMASK & (1 << 8))) { pg8::Gemm g{HB, (const bf16_t*)(ws + WS_WGU2), M, NGU, 1024}; pg8::StaticOrder S; S.init(M, NGU, G, bx);
        pg8::EpiGateUp<true> E{BIG, DFF, ssq2};
        pg8::gemm_phase<pg8::EpiGateUp<true>, pg8::StaticOrder, true, true>(lds, g, S, E); }
    SEAM(8);
    if (IN(9) && !(SKIPMASK & (1 << 9))) { pg8::Gemm g{BIG, (const bf16_t*)(ws + WS_WD2), M, 1024, DFF}; pg8::StaticOrder S; S.init(M, 1024, G, bx, WGM_N4);
        if (G == 256) { pg8::EpiFinal E{HB, out, ssq3, (unsigned*)(ws + WS_CTL) + 4096, a.in[21], 0.5f};
            pg8::gemm_phase<pg8::EpiFinal, pg8::StaticOrder, true, true>(lds, g, S, E); }
        else { pg8::EpiResid<false> E{nullptr, HB, ssq3, 0.5f, 1.0f};
            pg8::gemm_phase<pg8::EpiResid<false>, pg8::StaticOrder, true, true>(lds, g, S, E); } }
    if (G != 256) SEAM(9);
    if (IN(10) && !(SKIPMASK & (1 << 10)) && G != 256) {
        const int gw = bx * 8 + wave, NGW = G * 8; const float* fw = a.in[21];
        f32x4 wv[4];
#pragma unroll
        for (int jj = 0; jj < 4; ++jj) wv[jj] = ((const f32x4*)fw)[lane + 64 * jj];
        for (int m = gw; m < M; m += NGW) {
            const u32x2* hr = (const u32x2*)(HB + (size_t)m * D) + lane; f32x4* xr = (f32x4*)(out + (size_t)m * D) + lane;
            const float r = __builtin_amdgcn_rsqf(ssq3[m] * (1.0f / 1024.0f) + 1e-6f);
#pragma unroll
            for (int jj = 0; jj < 4; ++jj) { const u32x2 hv = hr[64 * jj];
                const f32x4 v = (f32x4){__uint_as_float(hv.x << 16), __uint_as_float(hv.x & 0xffff0000u), __uint_as_float(hv.y << 16), __uint_as_float(hv.y & 0xffff0000u)};
                xr[64 * jj] = v * r * wv[jj]; }
        }
    }
#undef IN
#undef SEAM
}

extern "C" void kernel_launch(void* const* d_in, const int* in_sizes, int n_in, void* d_out, int out_size, void* d_ws, size_t ws_size, hipStream_t stream) {
    static int grid = 0;
    if (grid == 0) {
        if (n_in != 22 || out_size != M * D || ws_size < WS_END) { fprintf(stderr, "kernel_launch: unexpected shapes (n_in %d out %d ws %zu)\n", n_in, out_size, ws_size); grid = -1; return; }
        int dev = 0, cus = 0, per_cu = 0;
        hipGetDevice(&dev); hipDeviceGetAttribute(&cus, hipDeviceAttributeMultiprocessorCount, dev);
        hipFuncSetAttribute((const void*)mega_fwd, hipFuncAttributeMaxDynamicSharedMemorySize, LDS_BYTES);
        hipOccupancyMaxActiveBlocksPerMultiprocessor(&per_cu, (const void*)mega_fwd, 512, LDS_BYTES);
        if (per_cu < 1) { fprintf(stderr, "kernel_launch: occupancy query says %d blocks per CU\n", per_cu); per_cu = 1; }
        (void)hipGetLastError();
        grid = cus * 1;
    }
    if (grid < 0) return;
    if (hipMemsetAsync((char*)d_ws + WS_CTL, 0, CTL_BYTES, stream) != hipSuccess) { fprintf(stderr, "kernel_launch: memset failed\n"); return; }
    Args a{};
    for (int i = 0; i < 22; ++i) a.in[i] = (const float*)d_in[i];
    a.out = (float*)d_out; a.ws = (unsigned char*)d_ws;
#if MK_PER_PHASE
    for (int p = 0; p < NPHASE; ++p) { a.ph_lo = p; a.ph_hi = p + 1; hipLaunchKernelGGL(mega_fwd, dim3(grid), dim3(512), LDS_BYTES, stream, a); }
#else
    a.ph_lo = 0; a.ph_hi = NPHASE;
    void* args[] = {&a};
    hipError_t e = hipLaunchCooperativeKernel((const void*)mega_fwd, dim3(grid), dim3(512), args, LDS_BYTES, stream);
    if (e != hipSuccess) fprintf(stderr, "cooperative launch failed: %s (grid %d)\n", hipGetErrorString(e), grid);
#endif
}
```

```cpp
#include <hip/hip_runtime.h>
#include <hip/hip_cooperative_groups.h>
#include <cstdio>
#include <cstdint>
namespace cg = cooperative_groups;
namespace pg8 {
#define PG8_LAS __attribute__((address_space(3)))
typedef unsigned short bf16_t;
typedef short bf16x8 __attribute__((ext_vector_type(8)));
typedef float f32x4 __attribute__((ext_vector_type(4)));
typedef unsigned u32x4 __attribute__((ext_vector_type(4)));
constexpr int BM = 256, BK = 64, HALF = 128, HTB = HALF * BK * 2  , STAGE_BYTES = 8 * HTB, NXCD = 8;

__host__ __device__ __forceinline__ int lds_byte(int r, int c) { const int st = (r >> 4) * 2 + (c >> 5), rr = r & 15, cc = c & 31, ob = rr * 64 + cc * 2; return st * 1024 + (ob ^ (((ob >> 9) & 1) << 5)); }
__host__ __device__ __forceinline__ void stage_rc(int b, int& R, int& C) { const int st = b / 1024, sb = b % 1024, swz = sb ^ (((sb >> 9) & 1) << 5); R = (st >> 1) * 16 + swz / 64; C = (st & 1) * 32 + (swz % 64) / 2; }
__host__ __device__ __forceinline__ int perm32(int rho) { const int n = rho >> 4, i = rho & 15; return 8 * (i >> 2) + 4 * n + (i & 3); }

struct Unit { int pm, pn; };
struct Gemm { const bf16_t* A; const bf16_t* Bt; int M, N, K; };

struct StaticOrder {
    int nM, nN, nwg, G, c, WGM;
    __host__ __device__ void init(int M, int N, int G_, int c_, int wgm = 4) { nM = M / BM; nN = N / BM; nwg = nM * nN; G = G_; c = c_; WGM = wgm; }
    __host__ __device__ bool next(int i, Unit& u) const {
        const long L = (long)i * G + c; if (L >= nwg) return false;
        int wgid = (int)L; { const int q = nwg / NXCD, r = nwg % NXCD, xcd = wgid % NXCD, off = wgid / NXCD; wgid = (xcd < r ? xcd * (q + 1) : r * (q + 1) + (xcd - r) * q) + off; }
        const int nig = WGM * nN, gid = wgid / nig, fm = gid * WGM, gsz = (nM - fm) < WGM ? (nM - fm) : WGM;
        u.pm = fm + ((wgid % nig) % gsz); u.pn = (wgid % nig) / gsz; return true;
    }
    __device__ __forceinline__ void a_ready(const Unit&) const {}
    __device__ __forceinline__ void done(const Unit&) const {}
};
typedef float f32x2_t __attribute__((ext_vector_type(2))); typedef __bf16 bf16x2_t __attribute__((ext_vector_type(2)));
__device__ __forceinline__ unsigned cvt_pk_bf16(float lo, float hi) { f32x2_t v = {lo, hi}; bf16x2_t b = __builtin_convertvector(v, bf16x2_t); return __builtin_bit_cast(unsigned, b); }
typedef unsigned u32x2 __attribute__((ext_vector_type(2)));
template <int X> __device__ __forceinline__ float xswz(float v) { return __int_as_float(__builtin_amdgcn_ds_swizzle(__float_as_int(v), 0x1f | (X << 10))); }
template <int X> __device__ __forceinline__ unsigned xswzu(unsigned v) { return (unsigned)__builtin_amdgcn_ds_swizzle((int)v, 0x1f | (X << 10)); }
__device__ __forceinline__ float sum_x32(float v) { auto rr = __builtin_amdgcn_permlane32_swap(__float_as_uint(v), __float_as_uint(v), false, false); return __uint_as_float(rr[0]) + __uint_as_float(rr[1]); }
__device__ __forceinline__ float max_x32(float v) { auto rr = __builtin_amdgcn_permlane32_swap(__float_as_uint(v), __float_as_uint(v), false, false); return fmaxf(__uint_as_float(rr[0]), __uint_as_float(rr[1])); }
__device__ __forceinline__ unsigned or_x32(unsigned v) { auto rr = __builtin_amdgcn_permlane32_swap(v, v, false, false); return rr[0] | rr[1]; }
__device__ __forceinline__ float sum_g(float v) { v += xswz<16>(v); return sum_x32(v); }
__device__ __forceinline__ float max_g(float v) { v = fmaxf(v, xswz<16>(v)); return max_x32(v); }

__device__ __forceinline__ float silu_f(float x) { return x * __builtin_amdgcn_rcpf(1.0f + __expf(-x)); }

template <bool SCALE> struct EpiGateUp {
    static constexpr bool PERM = true, AFTER_DRAIN = false; static constexpr int NEP = 8;
    bf16_t* O; int ldo; const float* ssq;
    __device__ __forceinline__ void operator()(const f32x4 (&acc)[2][2][4][2], const Unit& u, int wr, int wc, int fr, int fq) const {
        const int row0 = u.pm * BM + wr * 64 + fr, col0 = u.pn * HALF + wc * 32 + 8 * fq;
        float rs[8];
        if (SCALE) {
#pragma unroll
            for (int k = 0; k < 8; ++k) rs[k] = ssq[row0 + (k >> 2) * HALF + (k & 3) * 16];
#pragma unroll
            for (int k = 0; k < 8; ++k) rs[k] = __builtin_amdgcn_rsqf(rs[k] * (1.0f / 1024.0f) + 1e-6f);
        }
#pragma unroll
        for (int ai = 0; ai < 2; ++ai)
#pragma unroll
            for (int m = 0; m < 4; ++m) {
                const int row = row0 + ai * HALF + m * 16;
                const float r = SCALE ? rs[ai * 4 + m] : 1.0f, k1 = -1.4426950408889634f * r, r2 = r * r;
                typedef float f32x2 __attribute__((ext_vector_type(2)));
                unsigned wv[4];
#pragma unroll
                for (int n = 0; n < 2; ++n)
#pragma unroll
                    for (int p = 0; p < 2; ++p) {
                        const f32x2 g = (f32x2){acc[ai][0][m][n][2 * p], acc[ai][0][m][n][2 * p + 1]}, up = (f32x2){acc[ai][1][m][n][2 * p], acc[ai][1][m][n][2 * p + 1]};
                        const f32x2 t = g * k1; f32x2 ex; ex.x = __builtin_amdgcn_exp2f(t.x); ex.y = __builtin_amdgcn_exp2f(t.y);
                        const f32x2 d = ex + 1.0f; f32x2 rc; rc.x = __builtin_amdgcn_rcpf(d.x); rc.y = __builtin_amdgcn_rcpf(d.y);
                        f32x2 gu = g * up; if (SCALE) gu = gu * r2;
                        const f32x2 h = gu * rc;
                        wv[n * 2 + p] = cvt_pk_bf16(h.x, h.y);
                    }
                u32x4 w; w.x = wv[0]; w.y = wv[1]; w.z = wv[2]; w.w = wv[3];
                __builtin_nontemporal_store(w, (u32x4*)(O + (size_t)row * ldo + col0));
            }
    }
};

template <bool XF> struct EpiResid {
    static constexpr bool PERM = true, AFTER_DRAIN = false; static constexpr int NEP = 16;
    const float* xf; bf16_t* hb; float* ssq; float coef; float ssqw;
    __device__ __forceinline__ void ldbase(f32x4 (&b)[2][2], int row, int col0) const {
#pragma unroll
        for (int bj = 0; bj < 2; ++bj) { const size_t off = (size_t)row * 1024 + col0 + bj * HALF;
            if (XF) { b[bj][0] = __builtin_nontemporal_load((const f32x4*)(xf + off)); b[bj][1] = __builtin_nontemporal_load((const f32x4*)(xf + off + 4)); }
            else { const u32x4 hv = *(const u32x4*)(hb + off); b[bj][0] = __builtin_bit_cast(f32x4, hv); } }
    }
    __device__ __forceinline__ void operator()(const f32x4 (&acc)[2][2][4][2], const Unit& u, int wr, int wc, int fr, int fq) const {
        const int row0 = u.pm * BM + wr * 64 + fr, col0 = u.pn * BM + wc * 32 + 8 * fq;
        f32x4 bb[2][2][2];
        ldbase(bb[0], row0, col0);
#pragma unroll
        for (int k = 0; k < 8; ++k) {
            const int ai = k >> 2, m = k & 3, row = row0 + ai * HALF + m * 16;
            if (k + 1 < 8) ldbase(bb[(k + 1) & 1], row0 + ((k + 1) >> 2) * HALF + ((k + 1) & 3) * 16, col0);
            f32x4 ssv = (f32x4){0.f, 0.f, 0.f, 0.f};
#pragma unroll
            for (int bj = 0; bj < 2; ++bj) {
                const size_t off = (size_t)row * 1024 + col0 + bj * HALF;
                f32x4 b0, b1;
                if (XF) { b0 = bb[k & 1][bj][0]; b1 = bb[k & 1][bj][1]; }
                else { const u32x4 hv = __builtin_bit_cast(u32x4, bb[k & 1][bj][0]);
                    b0 = (f32x4){__uint_as_float(hv.x << 16), __uint_as_float(hv.x & 0xffff0000u), __uint_as_float(hv.y << 16), __uint_as_float(hv.y & 0xffff0000u)};
                    b1 = (f32x4){__uint_as_float(hv.z << 16), __uint_as_float(hv.z & 0xffff0000u), __uint_as_float(hv.w << 16), __uint_as_float(hv.w & 0xffff0000u)}; }
                const f32x4 v0 = b0 + acc[ai][bj][m][0] * coef, v1 = b1 + acc[ai][bj][m][1] * coef;
                ssv = ssv + v0 * v0; ssv = ssv + v1 * v1;
                u32x4 w; w.x = cvt_pk_bf16(v0[0], v0[1]); w.y = cvt_pk_bf16(v0[2], v0[3]); w.z = cvt_pk_bf16(v1[0], v1[1]); w.w = cvt_pk_bf16(v1[2], v1[3]); *(u32x4*)(hb + off) = w;
            }
            float ss = (ssv[0] + ssv[1]) + (ssv[2] + ssv[3]);
            ss = sum_g(ss) * ssqw;
            if (fq == 0) atomicAdd(ssq + row, ss);
        }
    }
};

struct EpiFinal {
    static constexpr bool PERM = true, AFTER_DRAIN = false; static constexpr int NEP = 32;
    const bf16_t* hb; float* out; float* ssq; unsigned* cnt; const float* w; float coef;
    __device__ __forceinline__ void ldbase(u32x4 (&b)[2], int row, int col0) const {
#pragma unroll
        for (int bj = 0; bj < 2; ++bj) b[bj] = *(const u32x4*)(hb + (size_t)row * 1024 + col0 + bj * HALF);
    }
    __device__ __forceinline__ void operator()(f32x4 (&acc)[2][2][4][2], const Unit& u, int wr, int wc, int fr, int fq) const {
        const int row0 = u.pm * BM + wr * 64 + fr, col0 = u.pn * BM + wc * 32 + 8 * fq;
        u32x4 bb[2][2];
        ldbase(bb[0], row0, col0);
#pragma unroll
        for (int k = 0; k < 8; ++k) {
            const int ai = k >> 2, m = k & 3, row = row0 + ai * HALF + m * 16;
            if (k + 1 < 8) ldbase(bb[(k + 1) & 1], row0 + ((k + 1) >> 2) * HALF + ((k + 1) & 3) * 16, col0);
            f32x4 ssv = (f32x4){0.f, 0.f, 0.f, 0.f};
#pragma unroll
            for (int bj = 0; bj < 2; ++bj) {
                const u32x4 hv = bb[k & 1][bj];
                const f32x4 b0 = (f32x4){__uint_as_float(hv.x << 16), __uint_as_float(hv.x & 0xffff0000u), __uint_as_float(hv.y << 16), __uint_as_float(hv.y & 0xffff0000u)};
                const f32x4 b1 = (f32x4){__uint_as_float(hv.z << 16), __uint_as_float(hv.z & 0xffff0000u), __uint_as_float(hv.w << 16), __uint_as_float(hv.w & 0xffff0000u)};
                const f32x4 v0 = b0 + acc[ai][bj][m][0] * coef, v1 = b1 + acc[ai][bj][m][1] * coef;
                acc[ai][bj][m][0] = v0; acc[ai][bj][m][1] = v1;
                ssv = ssv + v0 * v0; ssv = ssv + v1 * v1;
            }
            float ss = (ssv[0] + ssv[1]) + (ssv[2] + ssv[3]);
            ss = sum_g(ss);
            if (fq == 0) atomicAdd(ssq + row, ss);
        }
        asm volatile("s_waitcnt vmcnt(0)" ::: "memory");
        __builtin_amdgcn_s_barrier();
        if (threadIdx.x == 0) {
            __builtin_amdgcn_fence(__ATOMIC_RELEASE, "agent");
            __hip_atomic_fetch_add(cnt + 64 * u.pm, 1u, __ATOMIC_RELAXED, __HIP_MEMORY_SCOPE_AGENT);
            unsigned sp = 0;
            while (__hip_atomic_load(cnt + 64 * u.pm, __ATOMIC_RELAXED, __HIP_MEMORY_SCOPE_AGENT) < 4u) { __builtin_amdgcn_s_sleep(2); if (++sp > (1u << 20)) break; }
            __builtin_amdgcn_fence(__ATOMIC_ACQUIRE, "agent");
        }
        asm volatile("s_waitcnt vmcnt(0) lgkmcnt(0)" ::: "memory");
        __builtin_amdgcn_s_barrier();
        asm volatile("" ::: "memory");
        f32x4 wv[2][2];
#pragma unroll
        for (int bj = 0; bj < 2; ++bj) { wv[bj][0] = *(const f32x4*)(w + col0 + bj * HALF); wv[bj][1] = *(const f32x4*)(w + col0 + bj * HALF + 4); }
        float rs[8];
#pragma unroll
        for (int k = 0; k < 8; ++k) rs[k] = __hip_atomic_load(ssq + row0 + (k >> 2) * HALF + (k & 3) * 16, __ATOMIC_RELAXED, __HIP_MEMORY_SCOPE_AGENT);
#pragma unroll
        for (int k = 0; k < 8; ++k) rs[k] = __builtin_amdgcn_rsqf(rs[k] * (1.0f / 1024.0f) + 1e-6f);
#pragma unroll
        for (int ai = 0; ai < 2; ++ai)
#pragma unroll
            for (int m = 0; m < 4; ++m) {
                const int row = row0 + ai * HALF + m * 16;
                const float r = rs[ai * 4 + m];
#pragma unroll
                for (int bj = 0; bj < 2; ++bj) {
                    const size_t off = (size_t)row * 1024 + col0 + bj * HALF;
                    *(f32x4*)(out + off) = acc[ai][bj][m][0] * r * wv[bj][0]; *(f32x4*)(out + off + 4) = acc[ai][bj][m][1] * r * wv[bj][1];
                }
            }
    }
};

struct EpiIn {
    static constexpr bool PERM = true, AFTER_DRAIN = false; static constexpr int NEP = 16;
    bf16_t* P; bf16_t* QR; const float* ssq;
    __device__ __forceinline__ void operator()(const f32x4 (&acc)[2][2][4][2], const Unit& u, int wr, int wc, int fr, int fq) const {
        const int row0 = u.pm * BM + wr * 64 + fr, cw = wc * 32 + 8 * fq, col0 = u.pn * BM + cw;
        const int pn = u.pn;
        const int q8 = ((cw & 63) >> 3);
        const bool isret = pn <= 1, isnsa = (pn == 6 || pn == 7 || pn == 9 || pn == 10);
        f32x4 fr0 = (f32x4){0.f, 0.f, 0.f, 0.f}, fr1 = fr0;
        if (isret) {
#pragma unroll
            for (int j = 0; j < 4; ++j) fr0[j] = __builtin_amdgcn_exp2f(-(float)(4 * q8 + j) * (2.0f / 64.0f) * 13.287712379549449f) * 0.15915494309189535f;
        } else if (isnsa) {
#pragma unroll
            for (int j = 0; j < 4; ++j) { fr0[j] = __builtin_amdgcn_exp2f(-(float)j * (2.0f / 16.0f) * 18.931568569324174f) * 0.15915494309189535f;
                                          fr1[j] = __builtin_amdgcn_exp2f(-(float)(4 + j) * (2.0f / 16.0f) * 18.931568569324174f) * 0.15915494309189535f; }
        }
        float rs[8];
#pragma unroll
        for (int k = 0; k < 8; ++k) rs[k] = ssq[row0 + (k >> 2) * HALF + (k & 3) * 16];
#pragma unroll
        for (int k = 0; k < 8; ++k) rs[k] = __builtin_amdgcn_rsqf(rs[k] * (1.0f / 1024.0f) + 1e-6f);
#pragma unroll
        for (int ai = 0; ai < 2; ++ai)
#pragma unroll
            for (int m = 0; m < 4; ++m) {
                const int row = row0 + ai * HALF + m * 16; const float pos = (float)(row & 4095);
                const float r = rs[ai * 4 + m];
                f32x4 c0 = (f32x4){1.f, 1.f, 1.f, 1.f}, s0 = (f32x4){0.f, 0.f, 0.f, 0.f}, c1 = c0, s1 = s0;
                if (isret || isnsa) {
#pragma unroll
                    for (int j = 0; j < 4; ++j) { const float a0 = __builtin_amdgcn_fractf(pos * fr0[j]); c0[j] = __builtin_amdgcn_cosf(a0); s0[j] = __builtin_amdgcn_sinf(a0); }
                    if (isnsa) {
#pragma unroll
                        for (int j = 0; j < 4; ++j) { const float a1 = __builtin_amdgcn_fractf(pos * fr1[j]); c1[j] = __builtin_amdgcn_cosf(a1); s1[j] = __builtin_amdgcn_sinf(a1); }
                    }
                }
#pragma unroll
                for (int bj = 0; bj < 2; ++bj) {
                    f32x4 v0 = acc[ai][bj][m][0] * r, v1 = acc[ai][bj][m][1] * r;
                    bf16_t* dst = P + (size_t)row * 3072 + col0 + bj * HALF;
                    if (isret) {
                        f32x4 o0 = v0 * c0 - v1 * s0, o1 = v1 * c0 + v0 * s0;
                        if (pn == 1) { o0 = o0 * 0.125f; o1 = o1 * 0.125f; }
                        v0 = o0; v1 = o1;
                    } else if (pn == 6 || pn == 7 || ((pn == 9 || pn == 10) && bj == 0)) {
                        if (pn <= 7) { u32x4 w; w.x = cvt_pk_bf16(v0[0], v0[1]); w.y = cvt_pk_bf16(v0[2], v0[3]); w.z = cvt_pk_bf16(v1[0], v1[1]); w.w = cvt_pk_bf16(v1[2], v1[3]); *(u32x4*)dst = w;
                                       dst = QR + (size_t)row * 512 + (pn - 6) * BM + bj * HALF + cw; }
                        f32x4 p0, p1;
#pragma unroll
                        for (int j = 0; j < 4; ++j) { p0[j] = xswz<16>(v0[j]); p1[j] = xswz<16>(v1[j]); }
                        if (q8 == 0) { v0 = v0 * c0 - p0 * s0; v1 = v1 * c1 - p1 * s1; }
                        else if (q8 == 1) { v0 = v0 * c0 + p0 * s0; v1 = v1 * c1 + p1 * s1; }
                    }
                    u32x4 w; w.x = cvt_pk_bf16(v0[0], v0[1]); w.y = cvt_pk_bf16(v0[2], v0[3]); w.z = cvt_pk_bf16(v1[0], v1[1]); w.w = cvt_pk_bf16(v1[2], v1[3]);
                    __builtin_nontemporal_store(w, (u32x4*)dst);
                }
            }
    }
};
template <class Epi, class Sched, bool ALIGN_EPI = false, bool SP2 = false>
__device__ __forceinline__ void gemm_phase(PG8_LAS unsigned char* lds, const Gemm g, const Sched& S, const Epi& E) {
    const int tid = threadIdx.x, wid = __builtin_amdgcn_readfirstlane(tid >> 6), lane = tid & 63, wr = wid >> 2, wc = wid & 3, fr = lane & 15, fq = lane >> 4;
    const int K = g.K, nt = K / BK;
    unsigned voffA[2], voffB[2];
#pragma unroll
    for (int i = 0; i < 2; ++i) { int R, C; stage_rc(tid * 16 + i * 8192, R, C); const int Rb = Epi::PERM ? ((R & ~31) + perm32(R & 31)) : R;
        voffA[i] = (unsigned)(R * K + C) * 2u; voffB[i] = (unsigned)(Rb * K + C) * 2u; }
    const size_t kstep = (size_t)(BK * 2);
    const size_t hstep = (size_t)HALF * K * 2;
    const size_t tstep = 2 * hstep;
    const unsigned ldsw = (unsigned)wid * 1024u;
    const int aoff = lds_byte(wr * 64 + fr, fq * 8), boff = lds_byte(wc * 32 + fr, fq * 8);
#define PG8_SA(b, h) (((b) * 2 + (h)) * HTB)
#define PG8_SB(b, h) ((4 + (b) * 2 + (h)) * HTB)
#define PG8_STAGE(bufoff, gbase, voff) do { _Pragma("unroll") for (int _i = 0; _i < 2; ++_i) \
        __builtin_amdgcn_global_load_lds((const unsigned*)((const char*)(gbase) + (voff)[_i]), (PG8_LAS unsigned*)(lds + (bufoff) + ldsw + _i * 8192), 16, 0, 0); } while (0)
#define PG8_LDA(dst, b, h) do { _Pragma("unroll") for (int m = 0; m < 4; ++m) _Pragma("unroll") for (int k = 0; k < 2; ++k) dst[m][k] = *(const PG8_LAS bf16x8*)(lds + PG8_SA(b, h) + aoff + m * 2048 + k * 1024); } while (0)
#define PG8_LDB(dst, b, h) do { _Pragma("unroll") for (int n = 0; n < 2; ++n) _Pragma("unroll") for (int k = 0; k < 2; ++k) dst[n][k] = *(const PG8_LAS bf16x8*)(lds + PG8_SB(b, h) + boff + n * 2048 + k * 1024); } while (0)
#define PG8_MMA(ai, bj, At, Bt) do { __builtin_amdgcn_s_setprio(1); _Pragma("unroll") for (int m = 0; m < 4; ++m) _Pragma("unroll") for (int n = 0; n < 2; ++n) _Pragma("unroll") for (int k = 0; k < 2; ++k) \
        acc[ai][bj][m][n] = __builtin_amdgcn_mfma_f32_16x16x32_bf16(Bt[n][k], At[m][k], acc[ai][bj][m][n], 0, 0, 0); __builtin_amdgcn_s_setprio(0); } while (0)
#define PG8_WAIT_V(n) asm volatile("s_waitcnt vmcnt(" #n ")" ::: "memory")
#define PG8_WAIT_V8B asm volatile("s_waitcnt vmcnt(%1)\n\ts_cmp_eq_u32 %0, 0\n\ts_cbranch_scc1 1f\n\ts_waitcnt vmcnt(8)\n1:" :: "s"(strict), "n"(8 + Epi::NEP) : "memory", "scc")
#define PG8_WAIT_L(n) asm volatile("s_waitcnt lgkmcnt(" #n ")" ::: "memory")
#define PG8_BAR __builtin_amdgcn_s_barrier()
#define PG8_SCHED __builtin_amdgcn_sched_barrier(0)
    Unit cur, nxt; int ui = 0;
    if (!S.next(0, cur)) return;
    f32x4 acc[2][2][4][2];
#pragma unroll
    for (int a = 0; a < 2; ++a)
#pragma unroll
        for (int b = 0; b < 2; ++b)
#pragma unroll
            for (int m = 0; m < 4; ++m)
#pragma unroll
                for (int n = 0; n < 2; ++n) acc[a][b][m][n] = (f32x4){0.f, 0.f, 0.f, 0.f};
    bf16x8 At[4][2], B0[2][2], B1[2][2];
    const char* cA = (const char*)g.A + (size_t)cur.pm * tstep; const char* cB = (const char*)g.Bt + (size_t)cur.pn * tstep;
    S.a_ready(cur);
    if constexpr (SP2) {
        PG8_STAGE(PG8_SB(0, 0), cB, voffB); PG8_STAGE(PG8_SB(0, 1), cB + hstep, voffB); PG8_STAGE(PG8_SA(0, 0), cA, voffA); PG8_STAGE(PG8_SA(0, 1), cA + hstep, voffA);
        if (wr == 1) PG8_BAR;
        PG8_WAIT_V(2); PG8_BAR;
        PG8_STAGE(PG8_SB(1, 0), cB + kstep, voffB); PG8_STAGE(PG8_SA(1, 0), cA + kstep, voffA); PG8_STAGE(PG8_SB(1, 1), cB + hstep + kstep, voffB);
        PG8_WAIT_V(6); PG8_BAR;
    } else {
        PG8_STAGE(PG8_SB(0, 0), cB, voffB); PG8_STAGE(PG8_SA(0, 0), cA, voffA); PG8_STAGE(PG8_SB(0, 1), cB + hstep, voffB); PG8_STAGE(PG8_SA(0, 1), cA + hstep, voffA);
        if (wr == 1) PG8_BAR;
        PG8_WAIT_V(4); PG8_BAR;
        PG8_STAGE(PG8_SB(1, 0), cB + kstep, voffB); PG8_STAGE(PG8_SA(1, 0), cA + kstep, voffA); PG8_STAGE(PG8_SB(1, 1), cB + hstep + kstep, voffB);
        PG8_WAIT_V(6); PG8_BAR;
    }
    for (;;) {
        const bool has_next = S.next(ui + 1, nxt);
        const char* nA = has_next ? (const char*)g.A + (size_t)nxt.pm * tstep : cA; const char* nB = has_next ? (const char*)g.Bt + (size_t)nxt.pn * tstep : cB;
        for (int t = 0; t < nt; t += 2) {
            const bool last = (t == nt - 2);
            const char* a1 = cA + (size_t)(t + 1) * kstep;
            const char* a2 = last ? nA : cA + (size_t)(t + 2) * kstep; const char* b2 = last ? nB : cB + (size_t)(t + 2) * kstep;
            const char* a3 = a2 + kstep; const char* b3 = b2 + kstep;
            if (last && has_next) S.a_ready(nxt);
            const int strict = __builtin_amdgcn_readfirstlane((t == 0 && ui > 0) ? 0 : 1);
            if constexpr (SP2) {
            PG8_LDB(B0, 0, 0); PG8_LDB(B1, 0, 1); PG8_SCHED; PG8_LDA(At, 0, 0); PG8_STAGE(PG8_SA(1, 1), a1 + hstep, voffA);
            PG8_WAIT_V8B; PG8_WAIT_L(0); PG8_BAR; PG8_MMA(0, 0, At, B0); PG8_MMA(0, 1, At, B1); PG8_BAR; PG8_SCHED;
            PG8_LDA(At, 0, 1); PG8_STAGE(PG8_SB(0, 0), b2, voffB); PG8_STAGE(PG8_SB(0, 1), b2 + hstep, voffB); PG8_STAGE(PG8_SA(0, 0), a2, voffA);
            PG8_WAIT_V8B; PG8_WAIT_L(0); PG8_BAR; PG8_MMA(1, 0, At, B0); PG8_MMA(1, 1, At, B1); PG8_BAR; PG8_SCHED;
            PG8_LDB(B0, 1, 0); PG8_LDB(B1, 1, 1); PG8_SCHED; PG8_LDA(At, 1, 0); PG8_STAGE(PG8_SA(0, 1), a2 + hstep, voffA);
            PG8_WAIT_V(8); PG8_WAIT_L(0); PG8_BAR; PG8_MMA(0, 0, At, B0); PG8_MMA(0, 1, At, B1); PG8_BAR; PG8_SCHED;
            PG8_LDA(At, 1, 1); PG8_STAGE(PG8_SB(1, 0), b3, voffB); PG8_STAGE(PG8_SB(1, 1), b3 + hstep, voffB); PG8_STAGE(PG8_SA(1, 0), a3, voffA);
            PG8_WAIT_V(8); PG8_WAIT_L(0); PG8_BAR; PG8_MMA(1, 0, At, B0); PG8_MMA(1, 1, At, B1); PG8_BAR; PG8_SCHED;
            } else {
            PG8_LDB(B0, 0, 0); PG8_SCHED; PG8_LDA(At, 0, 0); PG8_STAGE(PG8_SA(1, 1), a1 + hstep, voffA);
            PG8_WAIT_L(8); PG8_BAR; PG8_WAIT_L(0); PG8_MMA(0, 0, At, B0); PG8_BAR; PG8_SCHED;
            PG8_LDB(B1, 0, 1); PG8_STAGE(PG8_SB(0, 0), b2, voffB);
            PG8_BAR; PG8_WAIT_L(0); PG8_MMA(0, 1, At, B1); PG8_BAR;
            PG8_LDA(At, 0, 1); PG8_STAGE(PG8_SA(0, 0), a2, voffA);
            PG8_BAR; PG8_WAIT_L(0); PG8_MMA(1, 0, At, B0); PG8_BAR; PG8_SCHED;
            PG8_STAGE(PG8_SB(0, 1), b2 + hstep, voffB);
            PG8_WAIT_V(6); PG8_BAR; PG8_MMA(1, 1, At, B1); PG8_BAR;
            PG8_LDB(B0, 1, 0); PG8_SCHED; PG8_LDA(At, 1, 0); PG8_STAGE(PG8_SA(0, 1), a2 + hstep, voffA);
            PG8_WAIT_L(8); PG8_BAR; PG8_WAIT_L(0); PG8_MMA(0, 0, At, B0); PG8_BAR; PG8_SCHED;
            PG8_LDB(B1, 1, 1); PG8_STAGE(PG8_SB(1, 0), b3, voffB);
            PG8_BAR; PG8_WAIT_L(0); PG8_MMA(0, 1, At, B1); PG8_BAR;
            PG8_LDA(At, 1, 1); PG8_STAGE(PG8_SA(1, 0), a3, voffA);
            PG8_BAR; PG8_WAIT_L(0); PG8_MMA(1, 0, At, B0); PG8_BAR; PG8_SCHED;
            PG8_STAGE(PG8_SB(1, 1), b3 + hstep, voffB);
            PG8_WAIT_V(6); PG8_BAR; PG8_MMA(1, 1, At, B1); PG8_BAR;
            }
        }
        if constexpr (ALIGN_EPI) { if (wr == 0) PG8_BAR; }
        if constexpr (!Epi::AFTER_DRAIN) { E(acc, cur, wr, wc, fr, fq); S.done(cur); }
        if (!has_next) break;
#pragma unroll
        for (int a = 0; a < 2; ++a)
#pragma unroll
            for (int b = 0; b < 2; ++b)
#pragma unroll
                for (int m = 0; m < 4; ++m)
#pragma unroll
                    for (int n = 0; n < 2; ++n) acc[a][b][m][n] = (f32x4){0.f, 0.f, 0.f, 0.f};
        cur = nxt; cA = nA; cB = nB; ++ui;
        if constexpr (ALIGN_EPI) { if (wr == 1) PG8_BAR; }
    }
    PG8_WAIT_V(0);
    if constexpr (!ALIGN_EPI) { if (wr == 0) PG8_BAR; }
    PG8_BAR;
    if constexpr (Epi::AFTER_DRAIN) { E.fused(acc, cur, wr, wc, fr, fq, lds, wid, lane); S.done(cur); }
#undef PG8_SA
#undef PG8_SB
#undef PG8_STAGE
#undef PG8_LDA
#undef PG8_LDB
#undef PG8_MMA
#undef PG8_WAIT_V
#undef PG8_WAIT_V8B
#undef PG8_WAIT_L
#undef PG8_BAR
#undef PG8_SCHED
}
}
using pg8::bf16_t; using pg8::bf16x8; using pg8::f32x4; using pg8::u32x4; using pg8::u32x2; using pg8::cvt_pk_bf16; using pg8::xswz; using pg8::xswzu; using pg8::sum_x32; using pg8::max_x32; using pg8::or_x32; using pg8::sum_g; using pg8::max_g;
#define LAS __attribute__((address_space(3)))
typedef LAS unsigned char* ldsp;
typedef short s16x4 __attribute__((ext_vector_type(4)));
typedef short v4i16_t __attribute__((ext_vector_type(4)));
__device__ __forceinline__ bf16x8 lds_rd16(ldsp p) { return *(const LAS bf16x8*)p; }
__device__ __forceinline__ s16x4 lds_tr(ldsp p) { return __builtin_bit_cast(s16x4, __builtin_amdgcn_ds_read_tr16_b64_v4i16((LAS v4i16_t*)p)); }
__device__ __forceinline__ bf16x8 cat4(s16x4 a, s16x4 b) { return (bf16x8){a[0], a[1], a[2], a[3], b[0], b[1], b[2], b[3]}; }
__device__ __forceinline__ bf16x8 pack8(const f32x4& a, const f32x4& b) {
    u32x4 w; w.x = cvt_pk_bf16(a[0], a[1]); w.y = cvt_pk_bf16(a[2], a[3]); w.z = cvt_pk_bf16(b[0], b[1]); w.w = cvt_pk_bf16(b[2], b[3]); return __builtin_bit_cast(bf16x8, w); }
__device__ __forceinline__ float bflo(unsigned w) { return __uint_as_float(w << 16); }
__device__ __forceinline__ float bfhi(unsigned w) { return __uint_as_float(w & 0xffff0000u); }
#define MFMA16(a, b, c) __builtin_amdgcn_mfma_f32_16x16x32_bf16((a), (b), (c), 0, 0, 0)
constexpr int P64 = 144, P128 = 272;
constexpr int LDP = 3072;
constexpr float C2 = 0.125f * 1.4426950408889634f;
constexpr float NEGB = -1e30f;

__device__ __forceinline__ float ret_log2g(int h) { return __log2f(1.0f - exp2f(-5.0f - (float)h)); }

template <int NIT> __device__ __forceinline__ void stage64(ldsp dst, const bf16_t* src, size_t ld, int rows, int tid) {
    u32x4 v[NIT];
#pragma unroll
    for (int i = 0; i < NIT; ++i) { const int idx = tid + 512 * i, r = idx >> 3, ch = idx & 7; if (idx < rows * 8) v[i] = *(const u32x4*)(src + (size_t)r * ld + ch * 8); }
#pragma unroll
    for (int i = 0; i < NIT; ++i) { const int idx = tid + 512 * i, r = idx >> 3, ch = idx & 7; if (idx < rows * 8) *(LAS u32x4*)(dst + r * P64 + ch * 16) = v[i]; }
}
template <int NIT> __device__ __forceinline__ void stage128(ldsp dst, const bf16_t* src, size_t ld, int rows, int tid) {
    u32x4 v[NIT];
#pragma unroll
    for (int i = 0; i < NIT; ++i) { const int idx = tid + 512 * i, r = idx >> 4, ch = idx & 15; if (idx < rows * 16) v[i] = *(const u32x4*)(src + (size_t)r * ld + ch * 8); }
#pragma unroll
    for (int i = 0; i < NIT; ++i) { const int idx = tid + 512 * i, r = idx >> 4, ch = idx & 15; if (idx < rows * 16) *(LAS u32x4*)(dst + r * P128 + ch * 16) = v[i]; }
}

__device__ __forceinline__ void ret_u_unit(ldsp lds, int unit, const bf16_t* P, float* ST) {
    int tid = threadIdx.x; asm volatile("" : "+v"(tid)); const int lane = tid & 63, w = __builtin_amdgcn_readfirstlane(tid >> 6), j = lane & 15, g = lane >> 4, r4 = j >> 2, cc = lane & 3;
    const int c = unit & 31, h = (unit >> 5) & 3, b = unit >> 7;
    const size_t row0 = (size_t)b * 4096 + c * 128;
    const float l2g = ret_log2g(h);
    const ldsp RK = lds, RV = lds + 18432;
    u32x4 kv[2];
#pragma unroll
    for (int i = 0; i < 2; ++i) { const int idx = tid + 512 * i, r = idx >> 3, ch = idx & 7; kv[i] = *(const u32x4*)(P + (row0 + r) * LDP + 256 + h * 64 + ch * 8); }
    stage128<4>(RV, P + row0 * LDP + 512 + h * 128, LDP, 128, tid);
#pragma unroll
    for (int i = 0; i < 2; ++i) { const int idx = tid + 512 * i, r = idx >> 3, ch = idx & 7; const u32x4 v = kv[i];
        const float z = exp2f((float)(127 - r) * l2g); u32x4 o;
        o.x = cvt_pk_bf16(bflo(v.x) * z, bfhi(v.x) * z); o.y = cvt_pk_bf16(bflo(v.y) * z, bfhi(v.y) * z); o.z = cvt_pk_bf16(bflo(v.z) * z, bfhi(v.z) * z); o.w = cvt_pk_bf16(bflo(v.w) * z, bfhi(v.w) * z);
        *(LAS u32x4*)(RK + r * P64 + ch * 16) = o; }
    __syncthreads();
    f32x4 acc[4];
#pragma unroll
    for (int dt = 0; dt < 4; ++dt) acc[dt] = (f32x4){0.f, 0.f, 0.f, 0.f};
#pragma unroll
    for (int ks = 0; ks < 4; ++ks) {
        const int tr0 = 32 * ks + 8 * g + r4;
        const bf16x8 vf = cat4(lds_tr(RV + tr0 * P128 + (16 * w + 4 * cc) * 2), lds_tr(RV + (tr0 + 4) * P128 + (16 * w + 4 * cc) * 2));
#pragma unroll
        for (int dt = 0; dt < 4; ++dt) {
            const bf16x8 kf = cat4(lds_tr(RK + tr0 * P64 + (16 * dt + 4 * cc) * 2), lds_tr(RK + (tr0 + 4) * P64 + (16 * dt + 4 * cc) * 2));
            acc[dt] = MFMA16(kf, vf, acc[dt]);
        }
    }
    float* U = ST + (size_t)unit * 8192;
#pragma unroll
    for (int dt = 0; dt < 4; ++dt)
#pragma unroll
        for (int e = 0; e < 4; ++e) U[(16 * dt + 4 * g + e) * 128 + 16 * w + j] = acc[dt][e];
    __syncthreads();
}

__device__ __forceinline__ void ret_out_unit(ldsp lds, int unit, const bf16_t* P, const float* ST, const float* gnw, bf16_t* MIX) {
    int tid = threadIdx.x; asm volatile("" : "+v"(tid)); const int lane = tid & 63, w = __builtin_amdgcn_readfirstlane(tid >> 6), j = lane & 15, g = lane >> 4, r4 = j >> 2, cc = lane & 3;
    const int c = unit & 31, h = (unit >> 5) & 3, b = unit >> 7;
    const size_t row0 = (size_t)b * 4096 + c * 128;
    const float l2g = ret_log2g(h);
    const ldsp OQ = lds, OK = lds + 18432, OV = lds + 36864, OS = lds + 71680;
    {
      u32x4 vq[2], vk[2], vv[4]; f32x4 vs[4];
      const float* S = ST + (size_t)unit * 8192;
#pragma unroll
      for (int i = 0; i < 2; ++i) { const int idx = tid + 512 * i, r = idx >> 3, ch = idx & 7; vq[i] = *(const u32x4*)(P + (row0 + r) * LDP + h * 64 + ch * 8); vk[i] = *(const u32x4*)(P + (row0 + r) * LDP + 256 + h * 64 + ch * 8); }
#pragma unroll
      for (int i = 0; i < 4; ++i) { const int idx = tid + 512 * i, r = idx >> 4, ch = idx & 15; vv[i] = *(const u32x4*)(P + (row0 + r) * LDP + 512 + h * 128 + ch * 8); }
#pragma unroll
      for (int k = 0; k < 4; ++k) { const int idx = tid + 512 * k, d = idx >> 5, e4 = idx & 31; vs[k] = *(const f32x4*)(S + d * 128 + 4 * e4); }
#pragma unroll
      for (int i = 0; i < 2; ++i) { const int idx = tid + 512 * i, r = idx >> 3, ch = idx & 7; *(LAS u32x4*)(OQ + r * P64 + ch * 16) = vq[i]; *(LAS u32x4*)(OK + r * P64 + ch * 16) = vk[i]; }
#pragma unroll
      for (int i = 0; i < 4; ++i) { const int idx = tid + 512 * i, r = idx >> 4, ch = idx & 15; *(LAS u32x4*)(OV + r * P128 + ch * 16) = vv[i]; }
#pragma unroll
      for (int k = 0; k < 4; ++k) { const int idx = tid + 512 * k, d = idx >> 5, e4 = idx & 31; u32x2 o; o.x = cvt_pk_bf16(vs[k][0], vs[k][1]); o.y = cvt_pk_bf16(vs[k][2], vs[k][3]); *(LAS u32x2*)(OS + d * P128 + e4 * 8) = o; }
    }
    __syncthreads();
    bf16x8 qf[2];
#pragma unroll
    for (int s = 0; s < 2; ++s) qf[s] = lds_rd16(OQ + (16 * w + j) * P64 + 64 * s + 16 * g);
    f32x4 tot[8];
#pragma unroll
    for (int et = 0; et < 8; ++et) tot[et] = (f32x4){0.f, 0.f, 0.f, 0.f};
#pragma unroll
    for (int ks = 0; ks < 2; ++ks) {
        const int tr0 = 32 * ks + 8 * g + r4;
#pragma unroll
        for (int et = 0; et < 8; ++et) {
            const bf16x8 sf = cat4(lds_tr(OS + tr0 * P128 + (16 * et + 4 * cc) * 2), lds_tr(OS + (tr0 + 4) * P128 + (16 * et + 4 * cc) * 2));
            tot[et] = MFMA16(sf, qf[ks], tot[et]);
        }
    }
    const int n = 16 * w + j;
    { const float xi = exp2f((float)(n + 1) * l2g);
#pragma unroll
      for (int et = 0; et < 8; ++et) tot[et] = tot[et] * xi; }
#pragma unroll
    for (int u = 0; u < 4; ++u) {
        if (2 * u <= w) {
            f32x4 s0 = (f32x4){0.f, 0.f, 0.f, 0.f}, s1 = (f32x4){0.f, 0.f, 0.f, 0.f};
#pragma unroll
            for (int s = 0; s < 2; ++s) {
                s0 = MFMA16(lds_rd16(OK + (32 * u + j) * P64 + 64 * s + 16 * g), qf[s], s0);
                s1 = MFMA16(lds_rd16(OK + (32 * u + 16 + j) * P64 + 64 * s + 16 * g), qf[s], s1);
            }
#pragma unroll
            for (int e = 0; e < 4; ++e) { const int d0 = n - (32 * u + 4 * g + e), d1 = d0 - 16;
                s0[e] = d0 >= 0 ? s0[e] * exp2f((float)d0 * l2g) : 0.f; s1[e] = d1 >= 0 ? s1[e] * exp2f((float)d1 * l2g) : 0.f; }
            const bf16x8 pf = pack8(s0, s1);
            const int tr0 = 32 * u + 4 * g + r4;
#pragma unroll
            for (int et = 0; et < 8; ++et) {
                const bf16x8 vf = cat4(lds_tr(OV + tr0 * P128 + (16 * et + 4 * cc) * 2), lds_tr(OV + (tr0 + 16) * P128 + (16 * et + 4 * cc) * 2));
                tot[et] = MFMA16(vf, pf, tot[et]);
            }
        }
    }
    float s1 = 0.f;
#pragma unroll
    for (int et = 0; et < 8; ++et) s1 += (tot[et][0] + tot[et][1]) + (tot[et][2] + tot[et][3]);
    s1 = sum_g(s1);
    const float mu = s1 * (1.0f / 128.0f); float s2 = 0.f;
#pragma unroll
    for (int et = 0; et < 8; ++et) { tot[et] = tot[et] - mu; s2 += (tot[et][0] * tot[et][0] + tot[et][1] * tot[et][1]) + (tot[et][2] * tot[et][2] + tot[et][3] * tot[et][3]); }
    s2 = sum_g(s2);
    const float rs = __builtin_amdgcn_rsqf(s2 * (1.0f / 128.0f) + 1e-5f);
    const size_t row = row0 + n;
    f32x4 gwv[8]; u32x2 rgw[8];
#pragma unroll
    for (int et = 0; et < 8; ++et) { const int e0 = h * 128 + 16 * et + 4 * g; gwv[et] = *(const f32x4*)(gnw + e0); rgw[et] = *(const u32x2*)(P + row * LDP + 1024 + e0); }
#pragma unroll
    for (int et = 0; et < 8; ++et) {
        const int e0 = h * 128 + 16 * et + 4 * g;
        const f32x4 gw = gwv[et]; const u32x2 rgv = rgw[et];
        const float r0 = bflo(rgv.x), r1 = bfhi(rgv.x), r2 = bflo(rgv.y), r3 = bfhi(rgv.y);
        const float o0 = tot[et][0] * rs * gw[0] * pg8::silu_f(r0), o1 = tot[et][1] * rs * gw[1] * pg8::silu_f(r1);
        const float o2 = tot[et][2] * rs * gw[2] * pg8::silu_f(r2), o3 = tot[et][3] * rs * gw[3] * pg8::silu_f(r3);
        u32x2 o; o.x = cvt_pk_bf16(o0, o1); o.y = cvt_pk_bf16(o2, o3);
        *(u32x2*)(MIX + row * 1024 + e0) = o;
    }
    __syncthreads();
}

__device__ __forceinline__ float gelu_tanh(float x) {
    const float y = 0.7978845608028654f * (x + 0.044715f * x * x * x);
    const float e = __expf(2.0f * y);
    const float th = 1.0f - 2.0f * __builtin_amdgcn_rcpf(e + 1.0f);
    return 0.5f * x * (1.0f + th);
}
__device__ __forceinline__ void cmp_unit(ldsp lds, int unit, const bf16_t* P, const bf16_t* PEb, const bf16_t* W1t, const float* b1, const bf16_t* W2t, bf16_t* OUT, int srccol) {
    int tid = threadIdx.x; asm volatile("" : "+v"(tid)); const int lane = tid & 63, w = __builtin_amdgcn_readfirstlane(tid >> 6), j = lane & 15, g = lane >> 4;
    const int ct = unit & 7, grp = (unit >> 3) & 1, b = unit >> 4;
    const ldsp CS = lds, CP = lds + 76032, CH = lds + 80640;
    const size_t rowb = (size_t)b * 4096;
    { u32x4 sv[9];
#pragma unroll
      for (int i = 0; i < 9; ++i) { const int idx = tid + 512 * i, tt = idx >> 3, ch = idx & 7, tok = 512 * ct + tt;
          sv[i] = (u32x4){0u, 0u, 0u, 0u}; if (idx < 528 * 8 && tok < 4096) sv[i] = *(const u32x4*)(P + (rowb + tok) * LDP + srccol + grp * 64 + ch * 8); }
#pragma unroll
      for (int i = 0; i < 9; ++i) { const int idx = tid + 512 * i, tt = idx >> 3, ch = idx & 7;
          if (idx < 528 * 8) *(LAS u32x4*)(CS + ((tt & 15) * 33 + (tt >> 4)) * P64 + ch * 16) = sv[i]; } }
    if (tid < 256) { const int l = tid >> 3, ch = tid & 7; *(LAS u32x4*)(CP + l * P64 + ch * 16) = *(const u32x4*)(PEb + (l * 2 + grp) * 64 + ch * 8); }
    __syncthreads();
    f32x4 acc[2][3];
#pragma unroll
    for (int a = 0; a < 2; ++a)
#pragma unroll
        for (int m = 0; m < 3; ++m) acc[a][m] = (f32x4){0.f, 0.f, 0.f, 0.f};
    const bf16_t* wrow0 = W1t + (size_t)(32 * w + j) * 2048 + 8 * g;
    const bf16_t* wrow1 = wrow0 + 16 * 2048;
    const bf16x8 zf = (bf16x8){0, 0, 0, 0, 0, 0, 0, 0};
#pragma unroll 8
    for (int l = 0; l < 32; ++l) {
#pragma unroll
        for (int s = 0; s < 2; ++s) {
            const bf16x8 w0 = *(const bf16x8*)(wrow0 + 64 * l + 32 * s), w1 = *(const bf16x8*)(wrow1 + 64 * l + 32 * s);
            const int rb = (l & 15) * 33 + (l >> 4) + j;
            const bf16x8 a0 = lds_rd16(CS + rb * P64 + 64 * s + 16 * g), a1 = lds_rd16(CS + (rb + 16) * P64 + 64 * s + 16 * g);
            bf16x8 pf = lds_rd16(CP + l * P64 + 64 * s + 16 * g); pf = (j == 0) ? pf : zf;
            acc[0][0] = MFMA16(w0, a0, acc[0][0]); acc[0][1] = MFMA16(w0, a1, acc[0][1]); acc[0][2] = MFMA16(w0, pf, acc[0][2]);
            acc[1][0] = MFMA16(w1, a0, acc[1][0]); acc[1][1] = MFMA16(w1, a1, acc[1][1]); acc[1][2] = MFMA16(w1, pf, acc[1][2]);
        }
    }
#pragma unroll
    for (int a = 0; a < 2; ++a) {
        const f32x4 bb = *(const f32x4*)(b1 + 32 * w + 16 * a + 4 * g);
        f32x4 bv;
#pragma unroll
        for (int e = 0; e < 4; ++e) bv[e] = __shfl(acc[a][2][e], lane & 48) + bb[e];
#pragma unroll
        for (int m = 0; m < 2; ++m) {
            const f32x4 x = acc[a][m] + bv;
            u32x2 o; o.x = cvt_pk_bf16(gelu_tanh(x[0]), gelu_tanh(x[1])); o.y = cvt_pk_bf16(gelu_tanh(x[2]), gelu_tanh(x[3]));
            *(LAS u32x2*)(CH + (16 * m + j) * 528 + (32 * w + 16 * a + 4 * g) * 2) = o;
        }
    }
    __syncthreads();
    { const int mt = w >> 2, dt = w & 3; f32x4 a2 = (f32x4){0.f, 0.f, 0.f, 0.f};
#pragma unroll
      for (int ks = 0; ks < 8; ++ks) {
          const bf16x8 wf = *(const bf16x8*)(W2t + (size_t)(16 * dt + j) * 256 + 32 * ks + 8 * g);
          const bf16x8 hf = lds_rd16(CH + (16 * mt + j) * 528 + (32 * ks + 8 * g) * 2);
          a2 = MFMA16(wf, hf, a2);
      }
      const int cidx = 32 * ct + 16 * mt + j;
      u32x2 o; o.x = cvt_pk_bf16(a2[0], a2[1]); o.y = cvt_pk_bf16(a2[2], a2[3]);
      *(u32x2*)(OUT + ((size_t)(b * 2 + grp) * 256 + cidx) * 64 + 16 * dt + 4 * g) = o; }
    __syncthreads();
}

constexpr int NS_KC = 0, NS_VC = 36864, NS_KB = 73728, NS_VB = 92160, NS_IMP = 110592, NS_UNI = 127232;
#define EX2(x) __builtin_amdgcn_exp2f(x)
template <int MODE> __device__ __forceinline__ void nsa_block(ldsp KB, ldsp VB, const bf16x8 (&q)[2][2], f32x4 (&o)[2][4], f32x4 (&lacc)[2], float (&mref)[2], bool first, int jb, int qi, int tl, bool rowsel, int j, int g, int r4, int cc) {
    f32x4 S[2][4];
    {
        bf16x8 kf[4][2];
#pragma unroll
        for (int kt = 0; kt < 4; ++kt)
#pragma unroll
            for (int s = 0; s < 2; ++s) kf[kt][s] = lds_rd16(KB + (16 * kt + j) * P64 + 64 * s + 16 * g);
        __builtin_amdgcn_s_setprio(1);
        const f32x4 z4 = (f32x4){0.f, 0.f, 0.f, 0.f};
#pragma unroll
        for (int qt = 0; qt < 2; ++qt)
#pragma unroll
            for (int kt = 0; kt < 4; ++kt) { f32x4 a = MFMA16(kf[kt][0], q[qt][0], z4); a = MFMA16(kf[kt][1], q[qt][1], a); S[qt][kt] = a; }
        __builtin_amdgcn_s_setprio(0);
    }
    if (__any(mref[0] != 0.f || mref[1] != 0.f)) {
#pragma unroll
        for (int qt = 0; qt < 2; ++qt)
#pragma unroll
            for (int kt = 0; kt < 4; ++kt) S[qt][kt] = S[qt][kt] - mref[qt];
    }
    if (jb == qi) {
#pragma unroll
        for (int qt = 0; qt < 2; ++qt)
#pragma unroll
            for (int kt = 0; kt < 4; ++kt)
#pragma unroll
                for (int e = 0; e < 4; ++e) S[qt][kt][e] = (16 * kt + 4 * g + e <= tl) ? S[qt][kt][e] : NEGB;
    }
    if (MODE == 1 && jb == qi - 8) {
#pragma unroll
        for (int qt = 0; qt < 2; ++qt)
#pragma unroll
            for (int kt = 0; kt < 4; ++kt)
#pragma unroll
                for (int e = 0; e < 4; ++e) S[qt][kt][e] = (16 * kt + 4 * g + e > tl) ? S[qt][kt][e] : NEGB;
    }
    float mx[2];
#pragma unroll
    for (int qt = 0; qt < 2; ++qt) {
        float m0 = __builtin_fmaxf(S[qt][0][0], S[qt][0][1]);
        float m1 = __builtin_fmaxf(S[qt][0][2], S[qt][0][3]);
#pragma unroll
        for (int kt = 1; kt < 4; ++kt) { m0 = __builtin_fmaxf(__builtin_fmaxf(m0, S[qt][kt][0]), S[qt][kt][1]); m1 = __builtin_fmaxf(__builtin_fmaxf(m1, S[qt][kt][2]), S[qt][kt][3]); }
        m0 = __builtin_fmaxf(m0, m1);
        if (MODE == 0) m0 = rowsel ? m0 : NEGB;
        mx[qt] = max_g(m0);
    }
    if (__any(fmaxf(mx[0], mx[1]) > 8.0f)) {
#pragma unroll
        for (int qt = 0; qt < 2; ++qt) {
            const float d = fmaxf(mx[qt], 0.f);
            const float alpha = EX2(-d); mref[qt] += d;
#pragma unroll
            for (int kt = 0; kt < 4; ++kt) S[qt][kt] = S[qt][kt] - d;
#pragma unroll
            for (int dt = 0; dt < 4; ++dt) o[qt][dt] = o[qt][dt] * alpha;
            lacc[qt] = lacc[qt] * alpha;
        }
    }
    __builtin_amdgcn_sched_barrier(0);
    bf16x8 vf[2][4];
#pragma unroll
    for (int u = 0; u < 2; ++u) { const int tr0 = 32 * u + 4 * g + r4;
#pragma unroll
        for (int dt = 0; dt < 4; ++dt) vf[u][dt] = cat4(lds_tr(VB + tr0 * P64 + (16 * dt + 4 * cc) * 2), lds_tr(VB + (tr0 + 16) * P64 + (16 * dt + 4 * cc) * 2)); }
    const short one = 0x3F80; const bf16x8 ones = (bf16x8){one, one, one, one, one, one, one, one};
#pragma unroll
    for (int qt = 0; qt < 2; ++qt) {
#pragma unroll
        for (int kt = 0; kt < 4; ++kt)
#pragma unroll
            for (int e = 0; e < 4; ++e) S[qt][kt][e] = EX2(S[qt][kt][e]);
#pragma unroll
        for (int u = 0; u < 2; ++u) {
            bf16x8 p = pack8(S[qt][2 * u], S[qt][2 * u + 1]);
            if (MODE == 0) { const bf16x8 z = (bf16x8){0, 0, 0, 0, 0, 0, 0, 0}; p = rowsel ? p : z; }
#pragma unroll
            for (int dt = 0; dt < 4; ++dt) o[qt][dt] = MFMA16(vf[u][dt], p, o[qt][dt]);
            lacc[qt] = MFMA16(ones, p, lacc[qt]);
        }
    }
    __builtin_amdgcn_sched_group_barrier(0x100, 16, 0);
    __builtin_amdgcn_sched_group_barrier(0x400, 16, 0);
    __builtin_amdgcn_sched_group_barrier(0x002, 12, 0);
#pragma unroll
    for (int i = 0; i < 10; ++i) { __builtin_amdgcn_sched_group_barrier(0x008, 1, 0); __builtin_amdgcn_sched_group_barrier(0x400, 2, 0); __builtin_amdgcn_sched_group_barrier(0x002, 2, 0); }
    __builtin_amdgcn_sched_group_barrier(0x008, 10, 0);
    __builtin_amdgcn_sched_barrier(0);
}

template <int MODE> __device__ __forceinline__ void nsa_branch(ldsp lds, const bf16_t* Kg, const bf16_t* Vg, const bf16x8 (&q)[2][2], f32x4 (&ofin)[2][4], const float (&gate)[2],
                                                               int qi, int tl, unsigned long long selm, unsigned long long unim, int jb0, int tid, int j, int g, int r4, int cc) {
    f32x4 o[2][4], lacc[2]; float mref[2] = {0.f, 0.f};
#pragma unroll
    for (int qt = 0; qt < 2; ++qt) { lacc[qt] = (f32x4){0.f, 0.f, 0.f, 0.f};
#pragma unroll
        for (int dt = 0; dt < 4; ++dt) o[qt][dt] = (f32x4){0.f, 0.f, 0.f, 0.f}; }
    const int kr = tid >> 3, kc8 = (tid & 7) * 8;
#define NXT(x) do { ++(x); while ((x) <= qi && !((unim >> (x)) & 1ull)) ++(x); } while (0)
#define LDKV(kd, vd, jj) do { if ((jj) <= qi) { kd = *(const u32x4*)(Kg + (size_t)(64 * (jj) + kr) * LDP + kc8); vd = *(const u32x4*)(Vg + (size_t)(64 * (jj) + kr) * LDP + kc8); } } while (0)
    int jb = jb0 - 1; NXT(jb);
    int jn = jb; NXT(jn);
    u32x4 k0 = (u32x4){0u, 0u, 0u, 0u}, v0 = k0, k1 = k0, v1 = k0;
    LDKV(k0, v0, jb); LDKV(k1, v1, jn);
    int buf = 0; bool first = true;
    while (jb <= qi) {
        const ldsp KB = lds + NS_KB + buf * 9216, VB = lds + NS_VB + buf * 9216;
        *(LAS u32x4*)(KB + kr * P64 + kc8 * 2) = k0; *(LAS u32x4*)(VB + kr * P64 + kc8 * 2) = v0;
        __syncthreads();
        int jnn = jn; NXT(jnn);
        k0 = k1; v0 = v1; LDKV(k1, v1, jnn);
        const bool rowsel = (MODE == 1) ? true : (((selm >> jb) & 1ull) != 0ull);
        nsa_block<MODE>(KB, VB, q, o, lacc, mref, first, jb, qi, tl, rowsel, j, g, r4, cc);
        jb = jn; jn = jnn; buf ^= 1; first = false;
    }
#undef NXT
#undef LDKV
#pragma unroll
    for (int qt = 0; qt < 2; ++qt) {
        const float ls = lacc[qt][0];
        const float sc = ls > 0.f ? gate[qt] / ls : 0.f;
#pragma unroll
        for (int dt = 0; dt < 4; ++dt) ofin[qt][dt] += o[qt][dt] * sc;
    }
    __syncthreads();
}

__device__ __forceinline__ bf16x8 scale8(bf16x8 v, float f) {
    const u32x4 w = __builtin_bit_cast(u32x4, v); u32x4 o;
    o.x = cvt_pk_bf16(bflo(w.x) * f, bfhi(w.x) * f); o.y = cvt_pk_bf16(bflo(w.y) * f, bfhi(w.y) * f); o.z = cvt_pk_bf16(bflo(w.z) * f, bfhi(w.z) * f); o.w = cvt_pk_bf16(bflo(w.w) * f, bfhi(w.w) * f);
    return __builtin_bit_cast(bf16x8, o);
}

__device__ __forceinline__ float sigmoid_f(float x) { return __builtin_amdgcn_rcpf(1.0f + __expf(-x)); }

__device__ __forceinline__ void nsa_unit(ldsp lds, int b, int grp, int qi, const bf16_t* P, const bf16_t* QR, const bf16_t* KCMP, const bf16_t* VCMP, bf16_t* MIX) {
    int tid = threadIdx.x; asm volatile("" : "+v"(tid)); const int lane = tid & 63, w = __builtin_amdgcn_readfirstlane(tid >> 6), j = lane & 15, g = lane >> 4, r4 = j >> 2, cc = lane & 3;
    const size_t rowbase = (size_t)b * 4096;
    const int nu = (((4 * qi + 3 + 15) >> 4) + 1) >> 1;
    { const bf16_t* kc = KCMP + (size_t)(b * 2 + grp) * 256 * 64; const bf16_t* vc = VCMP + (size_t)(b * 2 + grp) * 256 * 64;
      u32x4 ck[4], cv[4];
#pragma unroll
      for (int i = 0; i < 4; ++i) { const int idx = tid + 512 * i; if (idx < 32 * nu * 8) { ck[i] = *(const u32x4*)(kc + (size_t)idx * 8); cv[i] = *(const u32x4*)(vc + (size_t)idx * 8); } }
#pragma unroll
      for (int i = 0; i < 4; ++i) { const int idx = tid + 512 * i, r = idx >> 3, ch = idx & 7; if (idx < 32 * nu * 8) { *(LAS u32x4*)(lds + NS_KC + r * P64 + ch * 16) = ck[i]; *(LAS u32x4*)(lds + NS_VC + r * P64 + ch * 16) = cv[i]; } } }
    const int tl = 8 * w + (j & 7), t = qi * 64 + tl;
    const size_t row = rowbase + t;
    const int hg0 = 4 * grp + (j >> 3);
    float gates[3][2];
#pragma unroll
    for (int qt = 0; qt < 2; ++qt)
#pragma unroll
        for (int x = 0; x < 3; ++x) gates[x][qt] = sigmoid_f(__uint_as_float((unsigned)P[row * LDP + 2816 + (hg0 + 2 * qt) * 3 + x] << 16));
    bf16x8 q[2][2];
#pragma unroll
    for (int qt = 0; qt < 2; ++qt)
#pragma unroll
        for (int s = 0; s < 2; ++s) q[qt][s] = scale8(*(const bf16x8*)(P + row * LDP + 1536 + (hg0 + 2 * qt) * 64 + 32 * s + 8 * g), C2);
    __syncthreads();
    f32x4 ofin[2][4];
    LAS float* impl = (LAS float*)(lds + NS_IMP) + w * 8 * 65;
    unsigned selLo = 0u, selHi = 0u, uniLo = 0u, uniHi = 0u;
#ifndef NSA_REP_CMP
#define NSA_REP_CMP 1
#endif
    for (int rep_ = 0; rep_ < NSA_REP_CMP; ++rep_) {
    for (int i = lane; i < 8 * 65; i += 64) impl[i] = 0.f;
    const int nvalid = (t >= 31) ? ((t - 15) >> 4) : 0;
    {
        f32x4 oc[2][4];
#pragma unroll
        for (int qt = 0; qt < 2; ++qt)
#pragma unroll
            for (int dt = 0; dt < 4; ++dt) oc[qt][dt] = (f32x4){0.f, 0.f, 0.f, 0.f};
        float cref[2] = {0.f, 0.f}, lsum[2] = {0.f, 0.f}, prev[2] = {0.f, 0.f};
        float ia[2][8], ib[2][8];
#pragma unroll
        for (int qt = 0; qt < 2; ++qt)
#pragma unroll
            for (int u = 0; u < 8; ++u) { ia[qt][u] = 0.f; ib[qt][u] = 0.f; }
        const f32x4 z4 = (f32x4){0.f, 0.f, 0.f, 0.f};
#pragma unroll
        for (int u = 0; u < 8; ++u) {
            if (u < nu) {
                const bf16x8 ka0 = lds_rd16(lds + NS_KC + (32 * u + j) * P64 + 16 * g), ka1 = lds_rd16(lds + NS_KC + (32 * u + j) * P64 + 64 + 16 * g);
                const bf16x8 kb0 = lds_rd16(lds + NS_KC + (32 * u + 16 + j) * P64 + 16 * g), kb1 = lds_rd16(lds + NS_KC + (32 * u + 16 + j) * P64 + 64 + 16 * g);
                const int tr0 = 32 * u + 4 * g + r4;
                bf16x8 vf[4];
#pragma unroll
                for (int dt = 0; dt < 4; ++dt) vf[dt] = cat4(lds_tr(lds + NS_VC + tr0 * P64 + (16 * dt + 4 * cc) * 2), lds_tr(lds + NS_VC + (tr0 + 16) * P64 + (16 * dt + 4 * cc) * 2));
                f32x4 s0[2], s1[2]; float mloc[2];
#pragma unroll
                for (int qt = 0; qt < 2; ++qt) {
                    s0[qt] = MFMA16(ka0, q[qt][0], z4); s0[qt] = MFMA16(ka1, q[qt][1], s0[qt]); s1[qt] = MFMA16(kb0, q[qt][0], z4); s1[qt] = MFMA16(kb1, q[qt][1], s1[qt]);
                    float ml = NEGB;
#pragma unroll
                    for (int e = 0; e < 4; ++e) { const int c0 = 32 * u + 4 * g + e; s0[qt][e] = (c0 < nvalid) ? s0[qt][e] - cref[qt] : NEGB; s1[qt][e] = (c0 + 16 < nvalid) ? s1[qt][e] - cref[qt] : NEGB;
                        ml = __builtin_fmaxf(__builtin_fmaxf(ml, s0[qt][e]), s1[qt][e]); }
                    mloc[qt] = ml;
                }
                if (__any(fmaxf(mloc[0], mloc[1]) > 8.0f)) {
#pragma unroll
                    for (int qt = 0; qt < 2; ++qt) {
                        const float d = fmaxf(max_g(mloc[qt]), 0.f), alpha = EX2(-d); cref[qt] += d;
                        s0[qt] = s0[qt] - d; s1[qt] = s1[qt] - d; lsum[qt] *= alpha; prev[qt] *= alpha;
#pragma unroll
                        for (int dt = 0; dt < 4; ++dt) oc[qt][dt] = oc[qt][dt] * alpha;
#pragma unroll
                        for (int v = 0; v < 8; ++v) { ia[qt][v] *= alpha; ib[qt][v] *= alpha; }
                    }
                }
#pragma unroll
                for (int qt = 0; qt < 2; ++qt) {
#pragma unroll
                    for (int e = 0; e < 4; ++e) { s0[qt][e] = EX2(s0[qt][e]); s1[qt][e] = EX2(s1[qt][e]); }
                    lsum[qt] += ((s0[qt][0] + s0[qt][1]) + (s0[qt][2] + s0[qt][3])) + ((s1[qt][0] + s1[qt][1]) + (s1[qt][2] + s1[qt][3]));
                    float own0 = (s0[qt][0] + s0[qt][1]) + (s0[qt][2] + 0.5f * s0[qt][3]), own1 = (s1[qt][0] + s1[qt][1]) + (s1[qt][2] + 0.5f * s1[qt][3]);
                    const float car0 = 0.5f * s0[qt][3], car1 = 0.5f * s1[qt][3];
                    const float t0 = __shfl(car0, (lane + 48) & 63), t1 = __shfl(car1, (lane + 48) & 63);
                    own0 += (g == 0) ? prev[qt] : t0; own1 += (g == 0) ? t0 : t1; prev[qt] = t1;
                    ia[qt][u] = own0; ib[qt][u] = own1;
                    const bf16x8 pf = pack8(s0[qt], s1[qt]);
#pragma unroll
                    for (int dt = 0; dt < 4; ++dt) oc[qt][dt] = MFMA16(vf[dt], pf, oc[qt][dt]);
                }
            }
        }
        float inv[2];
#pragma unroll
        for (int qt = 0; qt < 2; ++qt) { const float lt = sum_g(lsum[qt]); inv[qt] = lt > 0.f ? 1.0f / lt : 0.f;
#pragma unroll
            for (int dt = 0; dt < 4; ++dt) ofin[qt][dt] = oc[qt][dt] * (inv[qt] * gates[0][qt]); }
#pragma unroll
        for (int u = 0; u < 8; ++u) {
            if (u < nu) {
                float a0 = ia[0][u] * inv[0] + ia[1][u] * inv[1], a1 = ib[0][u] * inv[0] + ib[1][u] * inv[1];
                a0 += xswz<8>(a0); a1 += xswz<8>(a1);
                if (j < 8) { impl[j * 65 + 8 * u + g] = a0; impl[j * 65 + 8 * u + 4 + g] = a1; }
            }
        }
    }
    if (qi < 16) {
        selLo = uniLo = (1u << (qi + 1)) - 1u; selHi = uniHi = 0u;
    } else {
        LAS unsigned* impu = (LAS unsigned*)impl;
        const int tok = lane >> 3, sub = lane & 7;
        unsigned myk[8]; int rank[8];
#pragma unroll
        for (int k = 0; k < 8; ++k) { const int s = sub + 8 * k; const bool forced = (s == 0) || (s == qi) || (s == qi - 1); const float v = impl[tok * 65 + s] + (forced ? 1e4f : 0.f);
            myk[k] = (s <= qi) ? ((__float_as_uint(v) & 0xFFFFFFC0u) | (unsigned)(63 - s)) : 0u; rank[k] = 0; }
#pragma unroll
        for (int k = 0; k < 8; ++k) impu[tok * 65 + sub + 8 * k] = myk[k];
#pragma unroll 8
        for (int sp = 0; sp < 64; ++sp) { const unsigned v = impu[tok * 65 + sp];
#pragma unroll
            for (int k = 0; k < 8; ++k) rank[k] += (v > myk[k]) ? 1 : 0; }
        unsigned mlo = 0u, mhi = 0u;
#pragma unroll
        for (int k = 0; k < 8; ++k) { const int s = sub + 8 * k; const bool sel = (rank[k] < 16) && (s <= qi); if (sel) { if (k < 4) mlo |= 1u << s; else mhi |= 1u << (s - 32); } }
        mlo |= xswzu<1>(mlo); mhi |= xswzu<1>(mhi); mlo |= xswzu<2>(mlo); mhi |= xswzu<2>(mhi); mlo |= xswzu<4>(mlo); mhi |= xswzu<4>(mhi);
        selLo = __shfl(mlo, (lane & 7) * 8); selHi = __shfl(mhi, (lane & 7) * 8);
        unsigned ulo = mlo, uhi = mhi;
        ulo |= xswzu<8>(ulo); uhi |= xswzu<8>(uhi); ulo |= xswzu<16>(ulo); uhi |= xswzu<16>(uhi); ulo = or_x32(ulo); uhi = or_x32(uhi);
        LAS unsigned* uni = (LAS unsigned*)(lds + NS_UNI);
        if (lane == 0) { uni[2 * w] = ulo; uni[2 * w + 1] = uhi; }
        __syncthreads();
        unsigned a = 0u, bq = 0u;
#pragma unroll
        for (int k = 0; k < 8; ++k) { a |= uni[2 * k]; bq |= uni[2 * k + 1]; }
        uniLo = __builtin_amdgcn_readfirstlane(a); uniHi = __builtin_amdgcn_readfirstlane(bq);
    }
    }
#pragma unroll
    for (int qt = 0; qt < 2; ++qt)
#pragma unroll
        for (int s = 0; s < 2; ++s) q[qt][s] = scale8(*(const bf16x8*)(QR + row * 512 + (hg0 + 2 * qt) * 64 + 32 * s + 8 * g), C2);
    { const float gsel[2] = {gates[1][0], gates[1][1]};
      nsa_branch<0>(lds, P + rowbase * LDP + 2304 + grp * 64, P + rowbase * LDP + 2432 + grp * 64, q, ofin, gsel, qi, tl, ((unsigned long long)selHi << 32) | selLo, ((unsigned long long)uniHi << 32) | uniLo, 0, tid, j, g, r4, cc); }
    { const float gwin[2] = {gates[2][0], gates[2][1]};
      nsa_branch<1>(lds, P + rowbase * LDP + 2560 + grp * 64, P + rowbase * LDP + 2688 + grp * 64, q, ofin, gwin, qi, tl, ~0ull, ~0ull, (qi >= 8 ? qi - 8 : 0), tid, j, g, r4, cc); }
#pragma unroll
    for (int qt = 0; qt < 2; ++qt)
#pragma unroll
        for (int dt = 0; dt < 4; ++dt) { u32x2 o; o.x = cvt_pk_bf16(ofin[qt][dt][0], ofin[qt][dt][1]); o.y = cvt_pk_bf16(ofin[qt][dt][2], ofin[qt][dt][3]);
            *(u32x2*)(MIX + row * 1024 + 512 + (hg0 + 2 * qt) * 64 + 16 * dt + 4 * g) = o; }
    __syncthreads();
}
#define XB_TMO      128
#define XB_XCNT(j)  (256  + 64 * (j))
#define XB_XSUB(j)  (1280 + 64 * (j))
#define XB_XGEN(j)  (2304 + 64 * (j))
#define XB_TOP      3328
#define XB_TOPGEN   3392
#define XCD_BAR_WORDS 3456
#define XB_SPIN_CAP (1u << 18)

__device__ __forceinline__ unsigned xb_ld(unsigned* p)              { return __hip_atomic_load(p, __ATOMIC_RELAXED, __HIP_MEMORY_SCOPE_AGENT); }
__device__ __forceinline__ unsigned xb_add(unsigned* p, unsigned v) { return __hip_atomic_fetch_add(p, v, __ATOMIC_RELAXED, __HIP_MEMORY_SCOPE_AGENT); }
__device__ __forceinline__ unsigned xb_xcc_id() { return (unsigned)__builtin_amdgcn_s_getreg((3 << 11) | 20) & 0xFu; }
#define XB_SPIN(cond, bar) do { unsigned _sp = 0; while (cond) { __builtin_amdgcn_s_sleep(1); \
    if ((++_sp & 255u) == 0u) { if (xb_ld(&(bar)[XB_TMO])) break; if (_sp > XB_SPIN_CAP) { atomicAdd(&(bar)[XB_TMO], 1u); break; } } } } while (0)

struct XcdBarrier {
    unsigned* bar; unsigned x;
    volatile LAS unsigned* st;
};

__device__ __forceinline__ XcdBarrier xcd_barrier_post(unsigned* bar, volatile LAS unsigned* st) {
    XcdBarrier b; b.bar = bar; b.x = xb_xcc_id(); b.st = st;
    if (threadIdx.x == 0) (void)xb_add(&bar[XB_XCNT(b.x)], 1u);
    return b;
}
__device__ __forceinline__ void xcd_barrier_complete(unsigned* bar, unsigned x, unsigned& nloc, unsigned& nx) {
    const unsigned G = gridDim.x * gridDim.y * gridDim.z;
    unsigned sum, cnt, mine, sp = 0u;
    for (;;) {
        sum = 0u; cnt = 0u; mine = 0u;
#pragma unroll
        for (unsigned j = 0; j < 16; ++j) { const unsigned c = xb_ld(&bar[XB_XCNT(j)]); sum += c; cnt += (c > 0u) ? 1u : 0u; mine = (j == x) ? c : mine; }
        if (sum == G) break;
        __builtin_amdgcn_s_sleep(1);
        if ((++sp & 255u) == 0u) { if (xb_ld(&bar[XB_TMO])) break; if (sp > XB_SPIN_CAP) { atomicAdd(&bar[XB_TMO], 1u); break; } }
    }
    nloc = mine > 0u ? mine : 1u; nx = cnt > 0u ? cnt : 1u;
}

__device__ __forceinline__ void xcd_barrier(const XcdBarrier& b) {
    asm volatile("s_waitcnt vmcnt(0)" ::: "memory");
    __syncthreads();
    if (threadIdx.x == 0) {
        unsigned* bar = b.bar;
        __builtin_amdgcn_s_waitcnt(0);
        unsigned nloc = b.st[0], nx = b.st[1];
        if (nloc == 0u) { xcd_barrier_complete(bar, b.x, nloc, nx); b.st[0] = nloc; b.st[1] = nx; }
        const unsigned old = xb_add(&bar[XB_XSUB(b.x)], 1u);
        const unsigned gen = old / nloc;
        if (old + 1u == (gen + 1u) * nloc) {
            __builtin_amdgcn_fence(__ATOMIC_RELEASE, "agent");
            asm volatile("s_waitcnt vmcnt(0)" ::: "memory");
            const unsigned og = xb_add(&bar[XB_TOP], 1u);
            const unsigned tg = og / nx;
            if (og + 1u == (tg + 1u) * nx) xb_add(&bar[XB_TOPGEN], 1u);
            else XB_SPIN(xb_ld(&bar[XB_TOPGEN]) == tg, bar);
            __builtin_amdgcn_fence(__ATOMIC_ACQUIRE, "agent");
            xb_add(&bar[XB_XGEN(b.x)], 1u);
            asm volatile("s_waitcnt vmcnt(0)" ::: "memory");
        } else {
            XB_SPIN(xb_ld(&bar[XB_XGEN(b.x)]) == gen, bar);
            __builtin_amdgcn_fence(__ATOMIC_ACQUIRE, "agent");
            asm volatile("s_waitcnt vmcnt(0)" ::: "memory");
        }
    }
    __syncthreads();
}
#ifndef MK_PER_PHASE
#define MK_PER_PHASE 0
#endif
constexpr int M = 32768, D = 1024, DFF = 2816, NGU = 5632, NIN = 3072, NINV = 2840;
constexpr size_t MiB = 1u << 20;
constexpr size_t WS_SSQ = 0;
constexpr size_t WS_ROPER = 1 * MiB, WS_ROPEN = 2 * MiB, WS_PE = 2 * MiB + 512 * 1024;
constexpr size_t WS_W1K = 3 * MiB, WS_W1V = 4 * MiB, WS_W2K = 5 * MiB, WS_W2V = 5 * MiB + 65536;
constexpr size_t WS_KCMP = 6 * MiB, WS_VCMP = 6 * MiB + 512 * 1024;
constexpr size_t WS_WGU1 = 8 * MiB, WS_WD1 = 20 * MiB, WS_WIN = 26 * MiB, WS_WOUT = 32 * MiB, WS_WGU2 = 34 * MiB, WS_WD2 = 46 * MiB;
constexpr size_t WS_STATE = 52 * MiB, WS_HB = 84 * MiB, WS_XB = 148 * MiB, WS_QROT = 212 * MiB, WS_BIG = 244 * MiB, WS_END = 436 * MiB;
constexpr size_t WS_CTL = 7 * MiB, CTL_BYTES = 65536;
constexpr int LDS_BYTES = 147456, MISC_OFF = 131072;
constexpr int NPHASE = 11;
#ifndef SKIPMASK
#define SKIPMASK 0
#endif
#ifndef WGM_N4
#define WGM_N4 8
#endif
#ifndef REPMASK
#define REPMASK 0
#endif

struct Args { const float* in[22]; float* out; unsigned char* ws; int ph_lo, ph_hi; };

__device__ __forceinline__ float wave_sum(float v) {
#pragma unroll
    for (int o = 1; o < 64; o <<= 1) v += __shfl_xor(v, o);
    return v;
}
__device__ __forceinline__ unsigned f2bf(float f) { unsigned u = __builtin_bit_cast(unsigned, f); return (u + 0x7fffu + ((u >> 16) & 1u)) >> 16; }
__device__ __forceinline__ unsigned pk2(float lo, float hi) { return f2bf(lo) | (f2bf(hi) << 16); }

__device__ __forceinline__ int rowmap(int mode, int n) {
    if (mode == 1) return 256 * (n >> 7) + (n & 127);
    if (mode == 2) return 256 * (n >> 7) + 128 + (n & 127);
    if (mode == 3 && n < 512) { const int hb = n >> 6, d = n & 63, dd = d & 31; return hb * 64 + 8 * (dd >> 2) + (d >= 32 ? 4 : 0) + (dd & 3); }
    return n;
}
__device__ __forceinline__ void p0_transpose_item(const float* W, int K, int ldw, int nvalid, const float* kscale, bf16_t* WT, int mode, LAS float* scr, int nblk, int item, int lane) {
    const int kb = item / nblk, nb = item % nblk, k0 = 64 * kb, n0 = 32 * nb;
    { const int kr = lane >> 3, c4 = (lane & 7) * 4; const bool ok = (n0 + c4) < nvalid;
      f32x4 v[8];
#pragma unroll
      for (int i = 0; i < 8; ++i) v[i] = ok ? *(const f32x4*)(W + (size_t)(k0 + kr + 8 * i) * ldw + n0 + c4) : (f32x4){0.f, 0.f, 0.f, 0.f};
#pragma unroll
      for (int i = 0; i < 8; ++i) { const int kk = kr + 8 * i; const float sc = kscale ? kscale[k0 + kk] : 1.0f;
          scr[kk * 33 + c4 + 0] = v[i][0] * sc; scr[kk * 33 + c4 + 1] = v[i][1] * sc; scr[kk * 33 + c4 + 2] = v[i][2] * sc; scr[kk * 33 + c4 + 3] = v[i][3] * sc; } }
    asm volatile("s_waitcnt lgkmcnt(0)" ::: "memory");
    const int c = lane & 7;
#pragma unroll
    for (int jj = 0; jj < 4; ++jj) { const int nn = (lane >> 3) + 8 * jj; const LAS float* s = scr + (8 * c) * 33 + nn;
        u32x4 o; o.x = pk2(s[0 * 33], s[1 * 33]); o.y = pk2(s[2 * 33], s[3 * 33]); o.z = pk2(s[4 * 33], s[5 * 33]); o.w = pk2(s[6 * 33], s[7 * 33]);
        *(u32x4*)(WT + (size_t)rowmap(mode, n0 + nn) * K + k0 + 8 * c) = o; }
    asm volatile("s_waitcnt lgkmcnt(0)" ::: "memory");
}

__global__ void __launch_bounds__(512, 2) mega_fwd(Args a) {
    extern __shared__ __attribute__((aligned(16))) unsigned char lds_raw[];
    ldsp lds = (ldsp)lds_raw;
    cg::grid_group grid = cg::this_grid();
    const int tid = threadIdx.x, lane = tid & 63, wave = __builtin_amdgcn_readfirstlane(tid >> 6);
    const int G = gridDim.x, bx = blockIdx.x;
    const int lo = a.ph_lo, hi = a.ph_hi;
    unsigned char* ws = a.ws;
    float* ssq0 = (float*)(ws + WS_SSQ); float* ssq1 = ssq0 + M; float* ssq2 = ssq1 + M; float* ssq3 = ssq2 + M;
    float* ropeR = (float*)(ws + WS_ROPER); float* ropeN = (float*)(ws + WS_ROPEN);
    bf16_t* PEb = (bf16_t*)(ws + WS_PE);
    bf16_t* HB = (bf16_t*)(ws + WS_HB); bf16_t* XB = (bf16_t*)(ws + WS_XB); bf16_t* QROT = (bf16_t*)(ws + WS_QROT); bf16_t* BIG = (bf16_t*)(ws + WS_BIG);
    float* ST = (float*)(ws + WS_STATE);
    bf16_t* KCMP = (bf16_t*)(ws + WS_KCMP); bf16_t* VCMP = (bf16_t*)(ws + WS_VCMP);
    float* out = a.out;
    volatile LAS unsigned* MISC = (volatile LAS unsigned*)(lds + MISC_OFF);
    if (tid < 16) MISC[tid] = 0u;
    __syncthreads();
    XcdBarrier bar = xcd_barrier_post((unsigned*)(ws + WS_CTL), MISC + 8);
#define IN(k) (lo <= (k) && (k) < hi)
#define SEAM(k) do { if (IN(k) && IN((k) + 1)) { if (lo < 0) grid.sync(); else xcd_barrier(bar); } } while (0)

    if (IN(0) && !(SKIPMASK & (1 << 0))) {
        for (int rep = 0; rep < (REPMASK & 1) + 1; ++rep) {
        LAS float* scr = (LAS float*)(lds + wave * 16384);
        const int gw = bx * 8 + wave, NGW = G * 8;
        constexpr int I_G = 16 * 88, I_D = 44 * 32, I_IN = 16 * 96, I_O = 16 * 32, I_C1 = 32 * 8, I_C2 = 4 * 2;
        constexpr int NITEMS = 4 * I_G + 2 * I_D + I_IN + I_O + 2 * I_C1 + 2 * I_C2;
        for (int it = gw; it < NITEMS; it += NGW) {
            int r = it;
            if (r < I_G) { p0_transpose_item(a.in[2], 1024, DFF, DFF, a.in[1], (bf16_t*)(ws + WS_WGU1), 1, scr, 88, r, lane); continue; } r -= I_G;
            if (r < I_G) { p0_transpose_item(a.in[3], 1024, DFF, DFF, a.in[1], (bf16_t*)(ws + WS_WGU1), 2, scr, 88, r, lane); continue; } r -= I_G;
            if (r < I_D) { p0_transpose_item(a.in[4], DFF, 1024, 1024, nullptr, (bf16_t*)(ws + WS_WD1), 0, scr, 32, r, lane); continue; } r -= I_D;
            if (r < I_IN) { p0_transpose_item(a.in[6], 1024, NINV, NINV, a.in[5], (bf16_t*)(ws + WS_WIN), 3, scr, 96, r, lane); continue; } r -= I_IN;
            if (r < I_O) { p0_transpose_item(a.in[16], 1024, 1024, 1024, nullptr, (bf16_t*)(ws + WS_WOUT), 0, scr, 32, r, lane); continue; } r -= I_O;
            if (r < I_G) { p0_transpose_item(a.in[18], 1024, DFF, DFF, a.in[17], (bf16_t*)(ws + WS_WGU2), 1, scr, 88, r, lane); continue; } r -= I_G;
            if (r < I_G) { p0_transpose_item(a.in[19], 1024, DFF, DFF, a.in[17], (bf16_t*)(ws + WS_WGU2), 2, scr, 88, r, lane); continue; } r -= I_G;
            if (r < I_D) { p0_transpose_item(a.in[20], DFF, 1024, 1024, nullptr, (bf16_t*)(ws + WS_WD2), 0, scr, 32, r, lane); continue; } r -= I_D;
            if (r < I_C1) { p0_transpose_item(a.in[9], 2048, 256, 256, nullptr, (bf16_t*)(ws + WS_W1K), 0, scr, 8, r, lane); continue; } r -= I_C1;
            if (r < I_C1) { p0_transpose_item(a.in[13], 2048, 256, 256, nullptr, (bf16_t*)(ws + WS_W1V), 0, scr, 8, r, lane); continue; } r -= I_C1;
            if (r < I_C2) { p0_transpose_item(a.in[11], 256, 64, 64, nullptr, (bf16_t*)(ws + WS_W2K), 0, scr, 2, r, lane); continue; } r -= I_C2;
            p0_transpose_item(a.in[15], 256, 64, 64, nullptr, (bf16_t*)(ws + WS_W2V), 0, scr, 2, r, lane);
        }
        const int gt = bx * 512 + tid, NGT = G * 512;
        for (int i = gt; i < 4096; i += NGT) { PEb[i] = (bf16_t)f2bf(a.in[8][i]); PEb[4096 + i] = (bf16_t)f2bf(a.in[12][i]); }
        for (int i = gt; i < 3 * M; i += NGT) ssq1[i] = 0.f;
        const float* x = a.in[0];
        for (int m = gw; m < M; m += 2 * NGW) {
            const int m2 = m + NGW; const bool has2 = m2 < M;
            const f32x4* xr = (const f32x4*)(x + (size_t)m * D) + lane; const f32x4* xr2 = (const f32x4*)(x + (size_t)(has2 ? m2 : m) * D) + lane;
            f32x4 v[4], v2[4]; float s = 0.f, s2 = 0.f;
#pragma unroll
            for (int jj = 0; jj < 4; ++jj) { v[jj] = __builtin_nontemporal_load(xr + 64 * jj); v2[jj] = __builtin_nontemporal_load(xr2 + 64 * jj); }
#pragma unroll
            for (int jj = 0; jj < 4; ++jj) { s += (v[jj][0] * v[jj][0] + v[jj][1] * v[jj][1]) + (v[jj][2] * v[jj][2] + v[jj][3] * v[jj][3]);
                                             s2 += (v2[jj][0] * v2[jj][0] + v2[jj][1] * v2[jj][1]) + (v2[jj][2] * v2[jj][2] + v2[jj][3] * v2[jj][3]); }
            s = wave_sum(s); s2 = wave_sum(s2);
            { const float r1 = __builtin_amdgcn_rsqf(s * (1.0f / 1024.0f) + 1e-6f), r2 = __builtin_amdgcn_rsqf(s2 * (1.0f / 1024.0f) + 1e-6f);
#pragma unroll
              for (int jj = 0; jj < 4; ++jj) { v[jj] = v[jj] * r1; v2[jj] = v2[jj] * r2; } }
            u32x2* o8 = (u32x2*)(XB + (size_t)m * D) + lane; u32x2* o82 = (u32x2*)(XB + (size_t)(has2 ? m2 : m) * D) + lane;
#pragma unroll
            for (int jj = 0; jj < 4; ++jj) { u32x2 o; o.x = cvt_pk_bf16(v[jj][0], v[jj][1]); o.y = cvt_pk_bf16(v[jj][2], v[jj][3]); o8[64 * jj] = o;
                if (has2) { u32x2 o2; o2.x = cvt_pk_bf16(v2[jj][0], v2[jj][1]); o2.y = cvt_pk_bf16(v2[jj][2], v2[jj][3]); o82[64 * jj] = o2; } }
        }
        }
        __syncthreads();
    }
    SEAM(0);
    if (REPMASK & 1024) { for (int k = 0; k < 10; ++k) grid.sync(); }
    if (IN(1) && !(SKIPMASK & (1 << 1))) { pg8::Gemm g{XB, (const bf16_t*)(ws + WS_WGU1), M, NGU, 1024}; pg8::StaticOrder S; S.init(M, NGU, G, bx);
        pg8::EpiGateUp<false> E{BIG, DFF, nullptr};
        pg8::gemm_phase<pg8::EpiGateUp<false>, pg8::StaticOrder, true, true>(lds, g, S, E);
        if (REPMASK & 2) pg8::gemm_phase<pg8::EpiGateUp<false>, pg8::StaticOrder, true, true>(lds, g, S, E); }
    SEAM(1);
    if (IN(2) && !(SKIPMASK & (1 << 2))) { pg8::Gemm g{BIG, (const bf16_t*)(ws + WS_WD1), M, 1024, DFF}; pg8::StaticOrder S; S.init(M, 1024, G, bx, WGM_N4);
        pg8::EpiResid<true> E{a.in[0], HB, ssq1, 0.5f, (REPMASK & 4) ? 0.5f : 1.0f};
        pg8::gemm_phase<pg8::EpiResid<true>, pg8::StaticOrder, true, true>(lds, g, S, E);
        if (REPMASK & 4) pg8::gemm_phase<pg8::EpiResid<true>, pg8::StaticOrder, true, true>(lds, g, S, E); }
    SEAM(2);
    if (IN(3) && !(SKIPMASK & (1 << 3))) { pg8::Gemm g{HB, (const bf16_t*)(ws + WS_WIN), M, NIN, 1024}; pg8::StaticOrder S; S.init(M, NIN, G, bx);
        pg8::EpiIn E{BIG, QROT, ssq1};
        pg8::gemm_phase<pg8::EpiIn, pg8::StaticOrder, true, true>(lds, g, S, E);
        if (REPMASK & 8) pg8::gemm_phase<pg8::EpiIn, pg8::StaticOrder, true, true>(lds, g, S, E); }
    SEAM(3);
    if (IN(4) && !(SKIPMASK & (1 << 4))) {
        for (int rep = 0; rep < ((REPMASK >> 4) & 1) + 1; ++rep)
        for (int u = bx; u < 1280; u += G) {
            if (u < 256) { const int kv = u >> 7;
                cmp_unit(lds, u & 127, BIG, PEb + kv * 4096, (const bf16_t*)(ws + (kv ? WS_W1V : WS_W1K)), a.in[kv ? 14 : 10], (const bf16_t*)(ws + (kv ? WS_W2V : WS_W2K)), kv ? VCMP : KCMP, kv ? 2176 : 2048); }
            else ret_u_unit(lds, u - 256, BIG, ST);
        }
    }
    SEAM(4);
    if (IN(5) && !(SKIPMASK & (1 << 5))) {
        unsigned* qctr = (unsigned*)(ws + WS_CTL) + 3584;
        unsigned* sctr = (unsigned*)(ws + WS_CTL) + 3648;
        constexpr int NSCAN = 64, U_NSA = NSCAN, U_RET = NSCAN + 1024, U_END = NSCAN + 2048;
        bool scan_ok = false;
        if (tid == 0) MISC[0] = __hip_atomic_fetch_add(qctr, 1u, __ATOMIC_RELAXED, __HIP_MEMORY_SCOPE_AGENT);
        __syncthreads();
        int u = __builtin_amdgcn_readfirstlane((int)MISC[0]);
        while (u < U_END) {
            unsigned nxt = 0u; if (tid == 0) nxt = __hip_atomic_fetch_add(qctr, 1u, __ATOMIC_RELAXED, __HIP_MEMORY_SCOPE_AGENT);
            if (u < U_NSA) {
                const int idx0 = u * 4096 + tid; const int bh = idx0 >> 13; const float gc = exp2f(128.0f * ret_log2g(bh & 3));
                float* p = ST + ((size_t)bh * 32 << 13) + (idx0 & 8191);
                float run[8];
#pragma unroll
                for (int k = 0; k < 8; ++k) run[k] = 0.f;
#pragma unroll 4
                for (int c = 0; c < 32; ++c) {
                    float uu[8];
#pragma unroll
                    for (int k = 0; k < 8; ++k) uu[k] = p[((size_t)c << 13) + 512 * k];
#pragma unroll
                    for (int k = 0; k < 8; ++k) { p[((size_t)c << 13) + 512 * k] = run[k]; run[k] = gc * run[k] + uu[k]; }
                }
                asm volatile("s_waitcnt vmcnt(0)" ::: "memory");
                __syncthreads();
                if (tid == 0) { __builtin_amdgcn_fence(__ATOMIC_RELEASE, "agent"); __hip_atomic_fetch_add(sctr, 1u, __ATOMIC_RELAXED, __HIP_MEMORY_SCOPE_AGENT); }
            } else if (u < U_RET) { const int v = u - U_NSA, qi = 63 - (v >> 4), bg = v & 15; nsa_unit(lds, bg >> 1, bg & 1, qi, BIG, QROT, KCMP, VCMP, XB); }
            else {
                if (!scan_ok) {
                    if (tid == 0) { unsigned sp = 0; while (__hip_atomic_load(sctr, __ATOMIC_RELAXED, __HIP_MEMORY_SCOPE_AGENT) < (unsigned)NSCAN) { __builtin_amdgcn_s_sleep(2); if (++sp > (1u << 22)) break; }
                                    __builtin_amdgcn_fence(__ATOMIC_ACQUIRE, "agent"); }
                    asm volatile("s_waitcnt vmcnt(0)" ::: "memory");
                    __syncthreads();
                    __builtin_amdgcn_fence(__ATOMIC_ACQUIRE, "agent");
                    scan_ok = true;
                }
                ret_out_unit(lds, u - U_RET, BIG, ST, a.in[7], XB);
            }
            if (tid == 0) MISC[0] = nxt;
            __syncthreads();
            u = __builtin_amdgcn_readfirstlane((int)MISC[0]);
        }
    }
    SEAM(5);
    if (IN(7) && !(SKIPMASK & (1 << 7))) { pg8::Gemm g{XB, (const bf16_t*)(ws + WS_WOUT), M, 1024, 1024}; pg8::StaticOrder S; S.init(M, 1024, G, bx, WGM_N4);
        pg8::EpiResid<false> E{nullptr, HB, ssq2, 1.0f, 1.0f};
        pg8::gemm_phase<pg8::EpiResid<false>, pg8::StaticOrder, true, true>(lds, g, S, E); }
    SEAM(7);
    if (IN(8) && !(SKIPMASK & (1 << 8))) { pg8::Gemm g{HB, (const bf16_t*)(ws + WS_WGU2), M, NGU, 1024}; pg8::StaticOrder S; S.init(M, NGU, G, bx);
        pg8::EpiGateUp<true> E{BIG, DFF, ssq2};
        pg8::gemm_phase<pg8::EpiGateUp<true>, pg8::StaticOrder, true, true>(lds, g, S, E); }
    SEAM(8);
    if (IN(9) && !(SKIPMASK & (1 << 9))) { pg8::Gemm g{BIG, (const bf16_t*)(ws + WS_WD2), M, 1024, DFF}; pg8::StaticOrder S; S.init(M, 1024, G, bx, WGM_N4);
        if (G == 256) { pg8::EpiFinal E{HB, out, ssq3, (unsigned*)(ws + WS_CTL) + 4096, a.in[21], 0.5f};
            pg8::gemm_phase<pg8::EpiFinal, pg8::StaticOrder, true, true>(lds, g, S, E); }
        else { pg8::EpiResid<false> E{nullptr, HB, ssq3, 0.5f, 1.0f};
            pg8::gemm_phase<pg8::EpiResid<false>, pg8::StaticOrder, true, true>(lds, g, S, E); } }
    if (G != 256) SEAM(9);
    if (IN(10) && !(SKIPMASK & (1 << 10)) && G != 256) {
        const int gw = bx * 8 + wave, NGW = G * 8; const float* fw = a.in[21];
        f32x4 wv[4];
#pragma unroll
        for (int jj = 0; jj < 4; ++jj) wv[jj] = ((const f32x4*)fw)[lane + 64 * jj];
        for (int m = gw; m < M; m += NGW) {
            const u32x2* hr = (const u32x2*)(HB + (size_t)m * D) + lane; f32x4* xr = (f32x4*)(out + (size_t)m * D) + lane;
            const float r = __builtin_amdgcn_rsqf(ssq3[m] * (1.0f / 1024.0f) + 1e-6f);
#pragma unroll
            for (int jj = 0; jj < 4; ++jj) { const u32x2 hv = hr[64 * jj];
                const f32x4 v = (f32x4){__uint_as_float(hv.x << 16), __uint_as_float(hv.x & 0xffff0000u), __uint_as_float(hv.y << 16), __uint_as_float(hv.y & 0xffff0000u)};
                xr[64 * jj] = v * r * wv[jj]; }
        }
    }
#undef IN
#undef SEAM
}

extern "C" void kernel_launch(void* const* d_in, const int* in_sizes, int n_in, void* d_out, int out_size, void* d_ws, size_t ws_size, hipStream_t stream) {
    static int grid = 0;
    if (grid == 0) {
        if (n_in != 22 || out_size != M * D || ws_size < WS_END) { fprintf(stderr, "kernel_launch: unexpected shapes (n_in %d out %d ws %zu)\n", n_in, out_size, ws_size); grid = -1; return; }
        int dev = 0, cus = 0, per_cu = 0;
        hipGetDevice(&dev); hipDeviceGetAttribute(&cus, hipDeviceAttributeMultiprocessorCount, dev);
        hipFuncSetAttribute((const void*)mega_fwd, hipFuncAttributeMaxDynamicSharedMemorySize, LDS_BYTES);
        hipOccupancyMaxActiveBlocksPerMultiprocessor(&per_cu, (const void*)mega_fwd, 512, LDS_BYTES);
        if (per_cu < 1) { fprintf(stderr, "kernel_launch: occupancy query says %d blocks per CU\n", per_cu); per_cu = 1; }
        (void)hipGetLastError();
        grid = cus * 1;
    }
    if (grid < 0) return;
    if (hipMemsetAsync((char*)d_ws + WS_CTL, 0, CTL_BYTES, stream) != hipSuccess) { fprintf(stderr, "kernel_launch: memset failed\n"); return; }
    Args a{};
    for (int i = 0; i < 22; ++i) a.in[i] = (const float*)d_in[i];
    a.out = (float*)d_out; a.ws = (unsigned char*)d_ws;
#if MK_PER_PHASE
    for (int p = 0; p < NPHASE; ++p) { a.ph_lo = p; a.ph_hi = p + 1; hipLaunchKernelGGL(mega_fwd, dim3(grid), dim3(512), LDS_BYTES, stream, a); }
#else
    a.ph_lo = 0; a.ph_hi = NPHASE;
    void* args[] = {&a};
    hipError_t e = hipLaunchCooperativeKernel((const void*)mega_fwd, dim3(grid), dim3(512), args, LDS_BYTES, stream);
    if (e != hipSuccess) fprintf(stderr, "cooperative launch failed: %s (grid %d)\n", hipGetErrorString(e), grid);
#endif
}
```
